# Optimizing an MI355X kernel written in HIP

```python
import math
import jax, jax.numpy as jnp
from jax import lax
import numpy as np

D_MODEL = 1024
BATCH = 2
SEQ = 16384
DEPTH = 4

HEAD_DIM = 64
BLOCK = 128
EPS = 1e-6
NEG = -1e30
A_Q_HEADS = 8
A_KV_HEADS = 2
A_GROUP = A_Q_HEADS // A_KV_HEADS
A_WINDOW = 128
B_BRANCHES = ((128, 1), (512, 4), (2048, 16))
B_HEADS_PER_BRANCH = 4
B_HEADS = len(B_BRANCHES) * B_HEADS_PER_BRANCH
NUM_BUCKETS = 32
MAX_DISTANCE = 2048
N_BIAS_HEADS = A_Q_HEADS + B_HEADS
A_IN = (A_Q_HEADS + 2 * A_KV_HEADS) * HEAD_DIM
B_IN = 3 * B_HEADS * HEAD_DIM
AB_IN = A_IN + B_IN
AB_OUT = (A_Q_HEADS + B_HEADS_PER_BRANCH) * HEAD_DIM
C_HEADS = 8
C_NOPE = 64
C_ROPE = 32
C_V = 64
C_Q_RANK = 384
C_KV_RANK = 256
C_DOWN = C_Q_RANK + C_KV_RANK + C_ROPE
ROPE_THETA = 10000.0
D_FF = 4 * D_MODEL
N_EVEN = (DEPTH + 1) // 2
N_ODD = DEPTH // 2

kernel_name = 'hybrid_swa_dilated_mla_trunk'


def rmsnorm(x, g):
    xf = x.astype(jnp.float32)
    y = xf * lax.rsqrt(jnp.mean(xf * xf, axis=-1, keepdims=True) + EPS)
    return (y * g.astype(jnp.float32)).astype(x.dtype)


def t5_bucket(n):
    max_exact = NUM_BUCKETS // 2
    nf = jnp.maximum(n, 1).astype(jnp.float32)
    large = max_exact + (jnp.log(nf / max_exact) / math.log(MAX_DISTANCE / max_exact)
                         * (NUM_BUCKETS - max_exact)).astype(jnp.int32)
    return jnp.where(n < max_exact, n, jnp.minimum(large, NUM_BUCKETS - 1))


def band_bias(table, dilation, max_dist):
    i = jnp.arange(BLOCK)[:, None]
    j = jnp.arange(2 * BLOCK)[None, :]
    dist = i + BLOCK - j
    inband = (dist >= 0) & (dist <= max_dist)
    bias = table[t5_bucket(jnp.maximum(dist, 0) * dilation)].astype(jnp.float32)
    bias = jnp.where(inband[..., None], bias, NEG)
    return bias.transpose(2, 0, 1)


def banded_attention(q, k, v, bias, sinks=None, with_lse=False):
    Bn, L, KVH, G, dh = q.shape
    n = L // BLOCK
    qb = q.reshape(Bn, n, BLOCK, KVH, G, dh)

    def two_blocks(t):
        cur = t.reshape(Bn, n, BLOCK, KVH, dh)
        prev = jnp.pad(cur, ((0, 0), (1, 0), (0, 0), (0, 0), (0, 0)))[:, :-1]
        return jnp.concatenate([prev, cur], axis=2)

    kb, vb = two_blocks(k), two_blocks(v)
    logits = jnp.einsum('bnqhgd,bnkhd->bnhgqk', qb, kb).astype(jnp.float32) * (dh ** -0.5)
    logits = logits + bias.reshape(KVH, G, BLOCK, 2 * BLOCK)
    first = (jnp.arange(n)[:, None] == 0) & (jnp.arange(2 * BLOCK)[None, :] < BLOCK)
    logits = jnp.where(first[None, :, None, None, None, :], NEG, logits)
    m = logits.max(axis=-1)
    if sinks is not None:
        s = sinks.astype(jnp.float32).reshape(KVH, G)[None, None, :, :, None]
        m = jnp.maximum(m, s)
    p = jnp.exp(logits - m[..., None])
    l = p.sum(axis=-1)
    if sinks is not None:
        l = l + jnp.exp(s - m)
    acc = jnp.einsum('bnhgqk,bnkhd->bnqhgd', p.astype(v.dtype), vb)
    o = (acc / l.transpose(0, 1, 4, 2, 3)[..., None].astype(v.dtype)).reshape(Bn, L, KVH, G, dh)
    if with_lse:
        lse = (m + jnp.log(l)).transpose(0, 1, 4, 2, 3).reshape(Bn, L, KVH, G)
        return o, lse
    return o


def dilate(t, d):
    Bn, S = t.shape[:2]
    L = S // d
    t = jnp.moveaxis(t.reshape((Bn, L, d) + t.shape[2:]), 2, 1).reshape((Bn * d, L) + t.shape[2:])
    pad = (-L) % BLOCK
    return jnp.pad(t, [(0, 0), (0, pad)] + [(0, 0)] * (t.ndim - 2))


def undilate(t, Bn, S, d):
    L = S // d
    t = t[:, :L].reshape((Bn, d, L) + t.shape[2:])
    return jnp.moveaxis(t, 1, 2).reshape((Bn, S) + t.shape[3:])


def even_mixer(xn, w_in, sinks, w_out, bias_a, bias_b):
    Bn, S, _ = xn.shape
    proj = xn @ w_in
    pa, pb = proj[..., :A_IN], proj[..., A_IN:]
    qd, kd = A_Q_HEADS * HEAD_DIM, A_KV_HEADS * HEAD_DIM
    qa = pa[..., :qd].reshape(Bn, S, A_KV_HEADS, A_GROUP, HEAD_DIM)
    ka = pa[..., qd:qd + kd].reshape(Bn, S, A_KV_HEADS, HEAD_DIM)
    va = pa[..., qd + kd:].reshape(Bn, S, A_KV_HEADS, HEAD_DIM)
    out_a = banded_attention(qa, ka, va, bias_a, sinks=sinks).reshape(Bn, S, qd)

    qkv_b = pb.reshape(Bn, S, len(B_BRANCHES), 3, B_HEADS_PER_BRANCH, HEAD_DIM)
    outs, lses = [], []
    for g, (window, dil) in enumerate(B_BRANCHES):
        q, k, v = (dilate(qkv_b[:, :, g, i], dil) for i in range(3))
        o, lse = banded_attention(q[:, :, :, None, :], k, v, bias_b[g], with_lse=True)
        outs.append(undilate(o[:, :, :, 0], Bn, S, dil))
        lses.append(undilate(lse[..., 0], Bn, S, dil))
    wts = jax.nn.softmax(jnp.stack(lses), axis=0)
    out_b = jnp.einsum('gbsh,gbshd->bshd', wts.astype(xn.dtype), jnp.stack(outs)).reshape(Bn, S, -1)
    return jnp.concatenate([out_a, out_b], axis=-1) @ w_out


def rope(t):
    S, r = t.shape[1], t.shape[-1]
    inv = ROPE_THETA ** (-jnp.arange(0, r, 2, dtype=jnp.float32) / r)
    ang = jnp.arange(S, dtype=jnp.float32)[:, None] * inv[None, :]
    shape = (1, S) + (1,) * (t.ndim - 3) + (r // 2,)
    cos, sin = jnp.cos(ang).reshape(shape), jnp.sin(ang).reshape(shape)
    t1, t2 = t[..., :r // 2].astype(jnp.float32), t[..., r // 2:].astype(jnp.float32)
    return jnp.concatenate([t1 * cos - t2 * sin, t1 * sin + t2 * cos], axis=-1).astype(t.dtype)


def causal_mla_attention(q_nope, q_rope, k_nope, k_rope, v):
    Bn, S, H, _ = q_nope.shape
    n = S // BLOCK
    scale = (C_NOPE + C_ROPE) ** -0.5
    kpos = jnp.arange(S)

    def block(args):
        qn, qr, i = args
        logits = (jnp.einsum('bqhd,bkhd->bhqk', qn, k_nope)
                  + jnp.einsum('bqhr,bkr->bhqk', qr, k_rope)).astype(jnp.float32) * scale
        qpos = i * BLOCK + jnp.arange(BLOCK)
        logits = jnp.where(kpos[None, :] <= qpos[:, None], logits, NEG)
        p = jax.nn.softmax(logits, axis=-1).astype(v.dtype)
        return jnp.einsum('bhqk,bkhd->bqhd', p, v)

    qn_b = q_nope.reshape(Bn, n, BLOCK, H, C_NOPE).transpose(1, 0, 2, 3, 4)
    qr_b = q_rope.reshape(Bn, n, BLOCK, H, C_ROPE).transpose(1, 0, 2, 3, 4)
    out = lax.map(block, (qn_b, qr_b, jnp.arange(n)))
    return out.transpose(1, 0, 2, 3, 4).reshape(Bn, S, H * C_V)


def mla_mixer(xn, w_down, q_norm, w_uq, kv_norm, w_ukv, w_o):
    Bn, S, _ = xn.shape
    down = xn @ w_down
    c_q = down[..., :C_Q_RANK]
    c_kv = down[..., C_Q_RANK:C_Q_RANK + C_KV_RANK]
    k_rope = rope(down[..., C_Q_RANK + C_KV_RANK:])
    q = (rmsnorm(c_q, q_norm) @ w_uq).reshape(Bn, S, C_HEADS, C_NOPE + C_ROPE)
    kv = (rmsnorm(c_kv, kv_norm) @ w_ukv).reshape(Bn, S, C_HEADS, C_NOPE + C_V)
    out = causal_mla_attention(q[..., :C_NOPE], rope(q[..., C_NOPE:]),
                               kv[..., :C_NOPE], k_rope, kv[..., C_NOPE:])
    return out @ w_o


def squared_relu_mlp(xn, w_up, w_down):
    h = jax.nn.relu(xn @ w_up)
    return (h * h) @ w_down


def setup_inputs(seed: int = 0) -> dict:
    key = jax.random.key(seed)
    ks = jax.random.split(key, 16)

    def w(k, shape, fan_in):
        return jax.random.normal(k, shape, jnp.float32) * fan_in ** -0.5

    def gain(k, shape):
        return 1.0 + 0.05 * jax.random.normal(k, shape, jnp.float32)

    return {
        'x': jax.random.normal(ks[0], (BATCH, SEQ, D_MODEL), jnp.float32),
        'rel_bias': 0.5 * jax.random.normal(ks[1], (NUM_BUCKETS, N_BIAS_HEADS), jnp.float32),
        'attn_norm': gain(ks[2], (DEPTH, D_MODEL)),
        'mlp_norm': gain(ks[3], (DEPTH, D_MODEL)),
        'final_norm': gain(ks[4], (D_MODEL,)),
        'w_in_ab': w(ks[5], (N_EVEN, D_MODEL, AB_IN), D_MODEL),
        'sinks': jax.random.normal(ks[6], (N_EVEN, A_Q_HEADS), jnp.float32),
        'w_out_ab': w(ks[7], (N_EVEN, AB_OUT, D_MODEL), AB_OUT),
        'w_down_c': w(ks[8], (N_ODD, D_MODEL, C_DOWN), D_MODEL),
        'q_norm_c': gain(ks[9], (N_ODD, C_Q_RANK)),
        'w_uq_c': w(ks[10], (N_ODD, C_Q_RANK, C_HEADS * (C_NOPE + C_ROPE)), C_Q_RANK),
        'kv_norm_c': gain(ks[11], (N_ODD, C_KV_RANK)),
        'w_ukv_c': w(ks[12], (N_ODD, C_KV_RANK, C_HEADS * (C_NOPE + C_V)), C_KV_RANK),
        'w_o_c': w(ks[13], (N_ODD, C_HEADS * C_V, D_MODEL), C_HEADS * C_V),
        'w_mlp_up': w(ks[14], (DEPTH, D_MODEL, D_FF), D_MODEL),
        'w_mlp_down': w(ks[15], (DEPTH, D_FF, D_MODEL), D_FF),
    }


def reference(x, rel_bias, attn_norm, mlp_norm, final_norm, w_in_ab, sinks, w_out_ab,
              w_down_c, q_norm_c, w_uq_c, kv_norm_c, w_ukv_c, w_o_c, w_mlp_up, w_mlp_down):
    bias_a = band_bias(rel_bias[:, :A_Q_HEADS], 1, A_WINDOW - 1)
    bias_b = [band_bias(rel_bias[:, A_Q_HEADS + g * B_HEADS_PER_BRANCH:A_Q_HEADS + (g + 1) * B_HEADS_PER_BRANCH],
                        dil, window // dil)
              for g, (window, dil) in enumerate(B_BRANCHES)]
    h = x
    for layer in range(DEPTH):
        xn = rmsnorm(h, attn_norm[layer])
        if layer % 2 == 0:
            e = layer // 2
            mix = even_mixer(xn, w_in_ab[e], sinks[e], w_out_ab[e], bias_a, bias_b)
        else:
            o = layer // 2
            mix = mla_mixer(xn, w_down_c[o], q_norm_c[o], w_uq_c[o], kv_norm_c[o], w_ukv_c[o], w_o_c[o])
        h = h + mix
        h = h + squared_relu_mlp(rmsnorm(h, mlp_norm[layer]), w_mlp_up[layer], w_mlp_down[layer])
    return rmsnorm(h, final_norm)
```

```cpp
#include <hip/hip_runtime.h>
#include <hip/hip_cooperative_groups.h>
#include <cstdio>
#include <cstdint>
namespace cg = cooperative_groups;

#define LAS __attribute__((address_space(3)))
#define DI __device__ __forceinline__
typedef unsigned short bf16_t;
typedef short bf16x8 __attribute__((ext_vector_type(8)));
typedef short s16x4 __attribute__((ext_vector_type(4)));
typedef float f32x4 __attribute__((ext_vector_type(4)));
typedef float f32x2 __attribute__((ext_vector_type(2)));
typedef float f32x16 __attribute__((ext_vector_type(16)));
typedef unsigned u32x4 __attribute__((ext_vector_type(4)));
typedef unsigned u32x2 __attribute__((ext_vector_type(2)));

constexpr int T_TOK = 32768, SEQ = 16384, DM = 1024, DFF = 4096;
constexpr float LOG2E = 1.4426950408889634f, LN2 = 0.6931471805599453f, EPSN = 1e-6f;
constexpr size_t MiB = 1u << 20;
constexpr size_t WS_HB = 0, WS_R = 64 * MiB, WS_OBUF = 320 * MiB, WS_W = 368 * MiB, WS_PARTH = 456 * MiB, WS_PARTO = 458 * MiB,
                 WS_ROPE = 462 * MiB, WS_LSE = 464 * MiB, WS_BIAS = 466 * MiB, WS_BAR = 467 * MiB, WS_RSTD = 468 * MiB, WS_END = 469 * MiB;
constexpr size_t R_PROJ = 0, R_ATT = 192 * MiB, R_DOWN = 0, R_Q = 48 * MiB, R_KV = 96 * MiB, R_KROPE = 160 * MiB, R_HID = 0;
constexpr size_t W_IN = 0, W_OUT = 6291456, W_DC = 7864320, W_UQ = 9437184, W_UKV = 10027008, W_O = 10551296, W_UP = 11599872, W_DN = 28377088;
constexpr int LDS_MAIN = 131072, LDS_RS = LDS_MAIN + 16, LDS_BYTES = LDS_RS + 16384;

#ifndef REP_SYNC
#define REP_SYNC 1
#endif
#ifndef REP_P0
#define REP_P0 1
#endif
#ifndef REP_O3
#define REP_O3 1
#endif
#ifndef REP_E2
#define REP_E2 1
#endif
#ifndef REP_M1
#define REP_M1 1
#endif
struct Params { const float* in[16]; float* out; unsigned char* ws; };

typedef __bf16 bf16x2_t __attribute__((ext_vector_type(2)));
typedef __bf16 bf16x8_t __attribute__((ext_vector_type(8)));
DI unsigned cvt_pk_bf16_mm(float lo, float hi) { const f32x2 v = {lo, hi}; return __builtin_bit_cast(unsigned, __builtin_convertvector(v, bf16x2_t)); }
DI unsigned cvt_pk_bf16(float lo, float hi) { unsigned r; asm("v_cvt_pk_bf16_f32 %0, %1, %2" : "=v"(r) : "v"(lo), "v"(hi)); return r; }
DI int opaque_tid() { int t = threadIdx.x; asm volatile("" : "+v"(t)); return t; }
DI float bf2f(bf16_t v) { return __uint_as_float(((unsigned)v) << 16); }
DI float bflo(unsigned u) { return __uint_as_float(u << 16); }
DI float bfhi(unsigned u) { return __uint_as_float(u & 0xffff0000u); }


#define XB_TMO      128
#define XB_XCNT(j)  (256  + 64 * (j))
#define XB_XSUB(j)  (1280 + 64 * (j))
#define XB_XGEN(j)  (2304 + 64 * (j))
#define XB_TOP      3328
#define XB_TOPGEN   3392
#define XCD_BAR_WORDS 3456
#define XB_SPIN_CAP (1u << 18)
DI unsigned xb_ld(unsigned* p)              { return __hip_atomic_load(p, __ATOMIC_RELAXED, __HIP_MEMORY_SCOPE_AGENT); }
DI unsigned xb_add(unsigned* p, unsigned v) { return __hip_atomic_fetch_add(p, v, __ATOMIC_RELAXED, __HIP_MEMORY_SCOPE_AGENT); }
DI unsigned xb_xcc_id() { return (unsigned)__builtin_amdgcn_s_getreg((3 << 11) | 20) & 0xFu; }
#define XB_SPIN(cond, bar) do { unsigned _sp = 0; while (cond) { __builtin_amdgcn_s_sleep(1); \
    if ((++_sp & 255u) == 0u) { if (xb_ld(&(bar)[XB_TMO])) break; if (_sp > XB_SPIN_CAP) { atomicAdd(&(bar)[XB_TMO], 1u); break; } } } } while (0)
struct XcdBarrier { unsigned* bar; unsigned x; volatile LAS unsigned* st; };
DI XcdBarrier xcd_barrier_post(unsigned* bar, volatile LAS unsigned* st) {
    XcdBarrier b; b.bar = bar; b.x = xb_xcc_id(); b.st = st;
    if (threadIdx.x == 0) (void)xb_add(&bar[XB_XCNT(b.x)], 1u);
    return b;
}
DI void xcd_barrier_complete(unsigned* bar, unsigned x, unsigned& nloc, unsigned& nx) {
    const unsigned G = gridDim.x * gridDim.y * gridDim.z;
    unsigned sum, cnt, mine, sp = 0u;
    for (;;) {
        sum = 0u; cnt = 0u; mine = 0u;
#pragma unroll
        for (unsigned j = 0; j < 16; ++j) { const unsigned c = xb_ld(&bar[XB_XCNT(j)]); sum += c; cnt += (c > 0u) ? 1u : 0u; mine = (j == x) ? c : mine; }
        if (sum == G) break;
        __builtin_amdgcn_s_sleep(1);
        if ((++sp & 255u) == 0u) { if (xb_ld(&bar[XB_TMO])) break; if (sp > XB_SPIN_CAP) { atomicAdd(&bar[XB_TMO], 1u); break; } }
    }
    nloc = mine > 0u ? mine : 1u; nx = cnt > 0u ? cnt : 1u;
}
DI void xcd_barrier(const XcdBarrier& b) {
    asm volatile("s_waitcnt vmcnt(0)" ::: "memory");
    __syncthreads();
    if (threadIdx.x == 0) {
        unsigned* bar = b.bar;
        __builtin_amdgcn_s_waitcnt(0);
        unsigned nloc = b.st[0], nx = b.st[1];
        if (nloc == 0u) { xcd_barrier_complete(bar, b.x, nloc, nx); b.st[0] = nloc; b.st[1] = nx; }
        const unsigned old = xb_add(&bar[XB_XSUB(b.x)], 1u);
        const unsigned gen = old / nloc;
        if (old + 1u == (gen + 1u) * nloc) {
            __builtin_amdgcn_fence(__ATOMIC_RELEASE, "agent");
            asm volatile("s_waitcnt vmcnt(0)" ::: "memory");
            const unsigned og = xb_add(&bar[XB_TOP], 1u);
            const unsigned tg = og / nx;
            if (og + 1u == (tg + 1u) * nx) xb_add(&bar[XB_TOPGEN], 1u);
            else XB_SPIN(xb_ld(&bar[XB_TOPGEN]) == tg, bar);
            __builtin_amdgcn_fence(__ATOMIC_ACQUIRE, "agent");
            xb_add(&bar[XB_XGEN(b.x)], 1u);
            asm volatile("s_waitcnt vmcnt(0)" ::: "memory");
        } else {
            XB_SPIN(xb_ld(&bar[XB_XGEN(b.x)]) == gen, bar);
            __builtin_amdgcn_fence(__ATOMIC_ACQUIRE, "agent");
            asm volatile("s_waitcnt vmcnt(0)" ::: "memory");
        }
    }
    __syncthreads();
}

namespace pg8 {
constexpr int BM = 256, BK = 64, HALF = 128, HTB = HALF * BK * 2, NXCD = 8, WGM = 8;
DI int lds_byte(int r, int c) { const int st = (r >> 4) * 2 + (c >> 5), rr = r & 15, cc = c & 31, ob = rr * 64 + cc * 2; return st * 1024 + (ob ^ (((ob >> 9) & 1) << 5)); }
DI void stage_rc(int b, int& R, int& C) { const int st = b / 1024, sb = b % 1024, swz = sb ^ (((sb >> 9) & 1) << 5); R = (st >> 1) * 16 + swz / 64; C = (st & 1) * 32 + (swz % 64) / 2; }
DI int perm32(int rho) { const int n = rho >> 4, i = rho & 15; return 8 * (i >> 2) + 4 * n + (i & 3); }
struct Unit { int pm, pn; };
struct Gemm { const bf16_t* A; int lda; const bf16_t* Bt; int M, N, K; };
struct StaticOrder {
    int nM, nN, nwg, G, c;
    DI void init(int M, int N, int G_, int c_) { nM = M / BM; nN = N / BM; nwg = nM * nN; G = G_; c = c_; }
    DI bool next(int i, Unit& u) const {
        const long L = (long)i * G + c; if (L >= nwg) return false;
        int wgid = (int)L; { const int q = nwg / NXCD, r = nwg % NXCD, xcd = wgid % NXCD, off = wgid / NXCD; wgid = (xcd < r ? xcd * (q + 1) : r * (q + 1) + (xcd - r) * q) + off; }
        const int nig = WGM * nN, gid = wgid / nig, fm = gid * WGM, gsz = (nM - fm) < WGM ? (nM - fm) : WGM;
        u.pm = fm + ((wgid % nig) % gsz); u.pn = (wgid % nig) / gsz; return true;
    }
};

struct Epi {
    int mode;
    bf16_t* O; int ldo; const float* rstd; int rs4; int relu2; float* part_out;
    template <int RELU2, int PART>
    DI void scale_store(const f32x4 (&acc)[2][2][4][2], const Unit& u, int wr, int wc, int fr, int fq, LAS const float* rsl) const {
            float rsv[2][4];
#pragma unroll
            for (int ai = 0; ai < 2; ++ai)
#pragma unroll
                for (int m = 0; m < 4; ++m) {
                    if (rs4) { const f32x4 v = ((LAS const f32x4*)rsl)[ai * 64 + m * 16 + fr]; rsv[ai][m] = __builtin_amdgcn_rsqf(((v[0] + v[1]) + (v[2] + v[3])) * (1.0f / 1024.0f) + EPSN); }
                    else rsv[ai][m] = rsl[ai * 64 + m * 16 + fr];
                }
#pragma unroll
            for (int ai = 0; ai < 2; ++ai)
#pragma unroll
                for (int m = 0; m < 4; ++m) {
                    const int row = u.pm * BM + ai * HALF + wr * 64 + m * 16 + fr;
                    const float rs = rsv[ai][m];
#pragma unroll
                    for (int bj = 0; bj < 2; ++bj) {
                        const int col = u.pn * BM + bj * HALF + wc * 32 + 8 * fq;
                        f32x4 v0 = acc[ai][bj][m][0] * rs, v1 = acc[ai][bj][m][1] * rs;
                        if (RELU2) {
#pragma unroll
                            for (int e = 0; e < 4; ++e) { const float a = fmaxf(v0[e], 0.f), b = fmaxf(v1[e], 0.f); v0[e] = a * a; v1[e] = b * b; }
                        }
                        u32x4 w; w.x = cvt_pk_bf16(v0[0], v0[1]); w.y = cvt_pk_bf16(v0[2], v0[3]); w.z = cvt_pk_bf16(v1[0], v1[1]); w.w = cvt_pk_bf16(v1[2], v1[3]);
                        *(u32x4*)(O + (size_t)row * ldo + col) = w;
                        if (PART) {
                            float sq = (v0[0] * v0[0] + v0[1] * v0[1]) + (v0[2] * v0[2] + v0[3] * v0[3]) + (v1[0] * v1[0] + v1[1] * v1[1]) + (v1[2] * v1[2] + v1[3] * v1[3]);
                            sq += __shfl_xor(sq, 16); sq += __shfl_xor(sq, 32);
                            if (fq == 0) part_out[(size_t)row * 32 + u.pn * 8 + bj * 4 + wc] = sq;
                        }
                    }
                }
    }
    DI void operator()(const f32x4 (&acc)[2][2][4][2], const Unit& u, int wr, int wc, int fr, int fq, LAS const float* rsl, LAS float* red) const {
        if (mode == 0) {
            if (relu2) scale_store<1, 0>(acc, u, wr, wc, fr, fq, rsl);
            else if (part_out) scale_store<0, 1>(acc, u, wr, wc, fr, fq, rsl);
            else scale_store<0, 0>(acc, u, wr, wc, fr, fq, rsl);
        } else {
#pragma unroll
            for (int ai = 0; ai < 2; ++ai) {
                u32x4 rr[4][2];
#pragma unroll
                for (int m = 0; m < 4; ++m)
#pragma unroll
                    for (int bj = 0; bj < 2; ++bj)
                        rr[m][bj] = *(const u32x4*)(O + (size_t)(u.pm * BM + ai * HALF + wr * 64 + m * 16 + fr) * DM + u.pn * BM + bj * HALF + wc * 32 + 8 * fq);
#pragma unroll
                for (int m = 0; m < 4; ++m) {
                    const int row = u.pm * BM + ai * HALF + wr * 64 + m * 16 + fr; float ss = 0.f;
#pragma unroll
                    for (int bj = 0; bj < 2; ++bj) {
                        const int col = u.pn * BM + bj * HALF + wc * 32 + 8 * fq;
                        const size_t o = (size_t)row * DM + col;
                        const u32x4 r = rr[m][bj];
                        f32x4 v0 = acc[ai][bj][m][0], v1 = acc[ai][bj][m][1];
                        v0[0] += bflo(r.x); v0[1] += bfhi(r.x); v0[2] += bflo(r.y); v0[3] += bfhi(r.y); v1[0] += bflo(r.z); v1[1] += bfhi(r.z); v1[2] += bflo(r.w); v1[3] += bfhi(r.w);
                        u32x4 w; w.x = cvt_pk_bf16(v0[0], v0[1]); w.y = cvt_pk_bf16(v0[2], v0[3]); w.z = cvt_pk_bf16(v1[0], v1[1]); w.w = cvt_pk_bf16(v1[2], v1[3]);
                        *(u32x4*)(O + o) = w;
                        ss += (v0[0] * v0[0] + v0[1] * v0[1]) + (v0[2] * v0[2] + v0[3] * v0[3]) + (v1[0] * v1[0] + v1[1] * v1[1]) + (v1[2] * v1[2] + v1[3] * v1[3]);
                    }
                    ss += __shfl_xor(ss, 16); ss += __shfl_xor(ss, 32);
                    if (fq == 0) red[(((wr * 4 + wc) * 8) + ai * 4 + m) * 16 + fr] = ss;
                }
            }
            asm volatile("s_waitcnt lgkmcnt(0)" ::: "memory"); __builtin_amdgcn_s_barrier(); asm volatile("" ::: "memory");
            const int lane = fq * 16 + fr;
            if (lane < 32) {
                const int q = 2 * wc + (lane >> 4), f2 = lane & 15;
                float t = 0.f;
#pragma unroll
                for (int w2 = 0; w2 < 4; ++w2) t += red[(((wr * 4 + w2) * 8) + q) * 16 + f2];
                const int row = u.pm * BM + (q >> 2) * HALF + wr * 64 + (q & 3) * 16 + f2;
                part_out[(size_t)row * 4 + u.pn] = t;
            }
        }
    }
};

DI void gemm_phase(LAS unsigned char* lds, const Gemm g, const StaticOrder& S, const Epi& E) {
    const int tid = opaque_tid(), wid = __builtin_amdgcn_readfirstlane(tid >> 6), lane = tid & 63, wr = wid >> 2, wc = wid & 3, fr = lane & 15, fq = lane >> 4;
    const int K = g.K, nt = K / BK, lda = g.lda;
    unsigned voffA[2], voffB[2];
#pragma unroll
    for (int i = 0; i < 2; ++i) { int R, C; stage_rc(tid * 16 + i * 8192, R, C); const int Rb = (R & ~31) + perm32(R & 31);
        voffA[i] = (unsigned)(R * lda + C) * 2u; voffB[i] = (unsigned)(Rb * K + C) * 2u; }
    const size_t kstep = (size_t)(BK * 2);
    const size_t hstepA = (size_t)HALF * lda * 2, hstepB = (size_t)HALF * K * 2;
    const size_t tstepA = 2 * hstepA, tstepB = 2 * hstepB;
    const unsigned ldsw = (unsigned)wid * 1024u;
    const int aoff = lds_byte(wr * 64 + fr, fq * 8), boff = lds_byte(wc * 32 + fr, fq * 8);
#define PG8_SA(b, h) (((b) * 2 + (h)) * HTB)
#define PG8_SB(b, h) ((4 + (b) * 2 + (h)) * HTB)
#define PG8_STAGE(bufoff, gbase, voff) do { _Pragma("unroll") for (int _i = 0; _i < 2; ++_i) \
        __builtin_amdgcn_global_load_lds((const unsigned*)((const char*)(gbase) + (voff)[_i]), (LAS unsigned*)(lds + (bufoff) + ldsw + _i * 8192), 16, 0, 0); } while (0)
#define PG8_LDA(dst, b, h) do { _Pragma("unroll") for (int m = 0; m < 4; ++m) _Pragma("unroll") for (int k = 0; k < 2; ++k) dst[m][k] = *(const LAS bf16x8*)(lds + PG8_SA(b, h) + aoff + m * 2048 + k * 1024); } while (0)
#define PG8_LDB(dst, b, h) do { _Pragma("unroll") for (int n = 0; n < 2; ++n) _Pragma("unroll") for (int k = 0; k < 2; ++k) dst[n][k] = *(const LAS bf16x8*)(lds + PG8_SB(b, h) + boff + n * 2048 + k * 1024); } while (0)
#define PG8_MMA(ai, bj, At, Bt) do { __builtin_amdgcn_s_setprio(1); _Pragma("unroll") for (int m = 0; m < 4; ++m) _Pragma("unroll") for (int n = 0; n < 2; ++n) _Pragma("unroll") for (int k = 0; k < 2; ++k) \
        acc[ai][bj][m][n] = __builtin_amdgcn_mfma_f32_16x16x32_bf16(Bt[n][k], At[m][k], acc[ai][bj][m][n], 0, 0, 0); __builtin_amdgcn_s_setprio(0); } while (0)
#define PG8_WAIT_V(n) asm volatile("s_waitcnt vmcnt(" #n ")" ::: "memory")
#define PG8_WAIT_L(n) asm volatile("s_waitcnt lgkmcnt(" #n ")" ::: "memory")
#define PG8_BAR __builtin_amdgcn_s_barrier()
#define PG8_SCHED __builtin_amdgcn_sched_barrier(0)
    Unit cur, nxt; int ui = 0;
    if (!S.next(0, cur)) return;
    f32x4 acc[2][2][4][2];
#pragma unroll
    for (int a = 0; a < 2; ++a)
#pragma unroll
        for (int b = 0; b < 2; ++b)
#pragma unroll
            for (int m = 0; m < 4; ++m)
#pragma unroll
                for (int n = 0; n < 2; ++n) acc[a][b][m][n] = (f32x4){0.f, 0.f, 0.f, 0.f};
    bf16x8 At[4][2], B0[2][2], B1[2][2];
    const char* cA = (const char*)g.A + (size_t)cur.pm * tstepA; const char* cB = (const char*)g.Bt + (size_t)cur.pn * tstepB;
    LAS float* rsl = (LAS float*)(lds + LDS_RS) + wid * 512;
#define PG8_RS_DMA(u_) do { if (E.mode == 0) { if (E.rs4) { _Pragma("unroll") for (int ai_ = 0; ai_ < 2; ++ai_) \
            __builtin_amdgcn_global_load_lds((const unsigned*)(E.rstd + (size_t)((u_).pm * BM + ai_ * HALF + wr * 64 + lane) * 4), (LAS unsigned*)(rsl + ai_ * 256), 16, 0, 0); } \
        else { _Pragma("unroll") for (int ai_ = 0; ai_ < 2; ++ai_) \
            __builtin_amdgcn_global_load_lds((const unsigned*)(E.rstd + (u_).pm * BM + ai_ * HALF + wr * 64 + lane), (LAS unsigned*)(rsl + ai_ * 64), 4, 0, 0); } } } while (0)
    PG8_RS_DMA(cur);
    PG8_STAGE(PG8_SB(0, 0), cB, voffB); PG8_STAGE(PG8_SB(0, 1), cB + hstepB, voffB); PG8_STAGE(PG8_SA(0, 0), cA, voffA); PG8_STAGE(PG8_SA(0, 1), cA + hstepA, voffA);
    if (wr == 1) PG8_BAR;
    PG8_WAIT_V(2); PG8_BAR;
    PG8_STAGE(PG8_SB(1, 0), cB + kstep, voffB); PG8_STAGE(PG8_SA(1, 0), cA + kstep, voffA); PG8_STAGE(PG8_SB(1, 1), cB + hstepB + kstep, voffB);
    PG8_WAIT_V(6); PG8_BAR;
    for (;;) {
        const bool has_next = S.next(ui + 1, nxt);
        const char* nA = has_next ? (const char*)g.A + (size_t)nxt.pm * tstepA : cA; const char* nB = has_next ? (const char*)g.Bt + (size_t)nxt.pn * tstepB : cB;
        for (int t = 0; t < nt; t += 2) {
            const bool last = (t == nt - 2);
            const char* a1 = cA + (size_t)(t + 1) * kstep;
            const char* a2 = last ? nA : cA + (size_t)(t + 2) * kstep; const char* b2 = last ? nB : cB + (size_t)(t + 2) * kstep;
            const char* a3 = a2 + kstep; const char* b3 = b2 + kstep;
            PG8_LDB(B0, 0, 0); PG8_LDB(B1, 0, 1); PG8_SCHED; PG8_LDA(At, 0, 0); PG8_STAGE(PG8_SA(1, 1), a1 + hstepA, voffA);
            PG8_WAIT_V(8); PG8_WAIT_L(0); PG8_BAR; PG8_MMA(0, 0, At, B0); PG8_MMA(0, 1, At, B1); PG8_BAR; PG8_SCHED;
            PG8_LDA(At, 0, 1); PG8_STAGE(PG8_SB(0, 0), b2, voffB); PG8_STAGE(PG8_SB(0, 1), b2 + hstepB, voffB); PG8_STAGE(PG8_SA(0, 0), a2, voffA);
            PG8_WAIT_V(8); PG8_WAIT_L(0); PG8_BAR; PG8_MMA(1, 0, At, B0); PG8_MMA(1, 1, At, B1); PG8_BAR; PG8_SCHED;
            PG8_LDB(B0, 1, 0); PG8_LDB(B1, 1, 1); PG8_SCHED; PG8_LDA(At, 1, 0); PG8_STAGE(PG8_SA(0, 1), a2 + hstepA, voffA);
            PG8_WAIT_V(8); PG8_WAIT_L(0); PG8_BAR; PG8_MMA(0, 0, At, B0); PG8_MMA(0, 1, At, B1); PG8_BAR; PG8_SCHED;
            PG8_LDA(At, 1, 1); PG8_STAGE(PG8_SB(1, 0), b3, voffB); PG8_STAGE(PG8_SB(1, 1), b3 + hstepB, voffB); PG8_STAGE(PG8_SA(1, 0), a3, voffA);
            PG8_WAIT_V(8); PG8_WAIT_L(0); PG8_BAR; PG8_MMA(1, 0, At, B0); PG8_MMA(1, 1, At, B1); PG8_BAR; PG8_SCHED;
        }
        if (wr == 0) PG8_BAR;
        E(acc, cur, wr, wc, fr, fq, rsl, (LAS float*)(lds + LDS_RS));
        if (!has_next) break;
        PG8_RS_DMA(nxt);
#pragma unroll
        for (int a = 0; a < 2; ++a)
#pragma unroll
            for (int b = 0; b < 2; ++b)
#pragma unroll
                for (int m = 0; m < 4; ++m)
#pragma unroll
                    for (int n = 0; n < 2; ++n) acc[a][b][m][n] = (f32x4){0.f, 0.f, 0.f, 0.f};
        cur = nxt; cA = nA; cB = nB; ++ui;
        if (wr == 1) PG8_BAR;
    }
    PG8_WAIT_V(0);
    PG8_BAR;
#undef PG8_RS_DMA
#undef PG8_SA
#undef PG8_SB
#undef PG8_STAGE
#undef PG8_LDA
#undef PG8_LDB
#undef PG8_MMA
#undef PG8_WAIT_V
#undef PG8_WAIT_L
#undef PG8_BAR
#undef PG8_SCHED
}

}

constexpr int AK_STRIDE = 208, AV_STRIDE = 192, AV_OFF = 64 * AK_STRIDE, A_STAGE = AV_OFF + 64 * AV_STRIDE, A_TAB = 4 * A_STAGE;
DI float max3f(float a, float b, float c) { float r; asm("v_max3_f32 %0, %1, %2, %3" : "=v"(r) : "v"(a), "v"(b), "v"(c)); return r; }
DI int crow(int i, int h) { return (i & 3) + 8 * (i >> 2) + 4 * h; }
#define MFMA32(a, b, c) __builtin_amdgcn_mfma_f32_32x32x16_bf16((a), (b), (c), 0, 0, 0)
typedef short v4i16_t __attribute__((ext_vector_type(4)));
DI s16x4 vtr(LAS const unsigned char* p) { return __builtin_bit_cast(s16x4, __builtin_amdgcn_ds_read_tr16_b64_v4i16((LAS v4i16_t*)p)); }

template <int V> struct AttTag { static constexpr int value = V; };
template <int MODE>
DI void attn_unit(LAS unsigned char* lds, const bf16_t* __restrict__ Qp, int ldq, const bf16_t* __restrict__ Kp, int ldk, const bf16_t* __restrict__ KRp,
                  const bf16_t* __restrict__ Vp, int ldv, bf16_t* __restrict__ Op, int ldo, float* __restrict__ lse_out, int ld_lse,
                  const float* __restrict__ rope_cs, const float* __restrict__ bias_g, float sink2, int has_sink, int W,
                  int tok0, int dil, int q0, float cscale) {
    constexpr int NKS = MODE == 0 ? 6 : 4;
    const int tid = opaque_tid(), wid = __builtin_amdgcn_readfirstlane(tid >> 6), lane = tid & 63, ql = lane & 31, h = lane >> 5;
    __builtin_assume(wid >= 0 && wid < 8);
    const int qa = q0 + 32 * wid, qb = qa + 31, qsub = qa + ql;
    const long qtok = (long)tok0 + (long)qsub * dil;
    bf16x8 qf[NKS];
    {
        const bf16_t* qptr = Qp + qtok * ldq;
#pragma unroll
        for (int s = 0; s < 4; ++s) qf[s] = *(const bf16x8*)(qptr + 16 * s + 8 * h);
        if constexpr (MODE == 0) {
            const u32x4 t1 = *(const u32x4*)(qptr + 64 + 8 * h), t2 = *(const u32x4*)(qptr + 80 + 8 * h);
            const float* cs = rope_cs + ((size_t)qsub * 16 + 8 * h) * 2;
            u32x4 o1, o2;
#pragma unroll
            for (int jj = 0; jj < 4; ++jj) {
                const f32x4 c4 = *(const f32x4*)(cs + 4 * jj);
                const float a0 = bflo(t1[jj]), a1 = bfhi(t1[jj]), b0 = bflo(t2[jj]), b1 = bfhi(t2[jj]);
                o1[jj] = cvt_pk_bf16_mm(a0 * c4[0] - b0 * c4[1], a1 * c4[2] - b1 * c4[3]);
                o2[jj] = cvt_pk_bf16_mm(a0 * c4[1] + b0 * c4[0], a1 * c4[3] + b1 * c4[2]);
            }
            qf[4] = __builtin_bit_cast(bf16x8, o1); qf[5] = __builtin_bit_cast(bf16x8, o2);
        }
    }
    int kt_lo = 0; const int kt_hi = (q0 >> 6) + 3;
    if constexpr (MODE == 1) { kt_lo = (q0 >> 6) - 2; if (kt_lo < 0) kt_lo = 0; }
    const bf16_t* dsrc[4]; unsigned dstr[4];
#pragma unroll
    for (int j = 0; j < 4; ++j) {
        const int c = (wid + 8 * j) * 64 + lane;
        const bf16_t* ptr; long strd;
        if (c < 832) {
            const int row = c / 13, col = c - row * 13;
            if (MODE == 0 && col >= 8 && col < 12) { ptr = KRp + ((long)tok0 + row) * 32 + (col - 8) * 8; strd = (long)64 * 32; }
            else { const int cc = (col < 8) ? col : 0; ptr = Kp + ((long)tok0 + (long)row * dil) * ldk + cc * 8; strd = (long)64 * dil * ldk; }
        } else if (c < 1600) {
            const int c2 = c - 832, row = c2 / 12, col = c2 - row * 12, cc = (col < 8) ? col : 0;
            ptr = Vp + ((long)tok0 + (long)row * dil) * ldv + cc * 8; strd = (long)64 * dil * ldv;
        } else { ptr = Vp + ((long)tok0) * ldv; strd = (long)64 * dil * ldv; }
        dsrc[j] = ptr + (long)kt_lo * strd; dstr[j] = (unsigned)(strd * 2);
    }
    LAS float* tab = (LAS float*)(lds + A_TAB);
    if constexpr (MODE == 1) tab[tid] = bias_g[tid];
#define ATT_DMA(ti_, stg_) do { if ((ti_) <= nt_m1) { \
        _Pragma("unroll") for (int j_ = 0; j_ < 4; ++j_) { const int slot_ = wid + 8 * j_; \
            if (slot_ < 25) __builtin_amdgcn_global_load_lds((const unsigned*)((const char*)dsrc[j_] + (size_t)(ti_) * dstr[j_]), (LAS unsigned*)(lds + (stg_) * A_STAGE + slot_ * 1024), 16, 0, 0); } } } while (0)
    const int nt_m1 = kt_hi - kt_lo;
    ATT_DMA(0, 0); ATT_DMA(1, 1);
    asm volatile("s_waitcnt vmcnt(0)" ::: "memory");
    __syncthreads();
    f32x16 o0, o1;
#pragma unroll
    for (int i = 0; i < 16; ++i) { o0[i] = 0.f; o1[i] = 0.f; }
    float mrun = -1e29f, lrun = 0.f;
    if (has_sink) { mrun = sink2; lrun = (h == 0) ? 1.f : 0.f; }
    const float sc = (MODE == 0) ? cscale : 1.0f;
    const unsigned kfo = ql * AK_STRIDE + h * 16;
    const unsigned vfo = AV_OFF + (4 * h + ((lane & 15) >> 2)) * AV_STRIDE + (16 * ((lane >> 4) & 1) + 4 * (lane & 3)) * 2;

#define ATT_ACT(kt_) (((kt_) <= kt_hi) && ((kt_) * 64 <= qb) && (MODE == 0 || ((kt_) * 64 + 63 >= qa - W)))
    f32x16 s0, s1;
    auto tile_body = [&](auto odd_tag, const int kt) __attribute__((always_inline)) {
        constexpr int ODD = decltype(odd_tag)::value;
        const int ti = kt - kt_lo, stg = ti & 3;
        const bool act_t = ATT_ACT(kt);
        if (!act_t && ODD == 0) { ATT_DMA(ti + 2, (ti + 2) & 3); ATT_DMA(ti + 3, (ti + 3) & 3); }
        if (act_t) {
            LAS const unsigned char* sb = lds + stg * A_STAGE;
            bf16x8 kf[2 * NKS];
#pragma unroll
            for (int s = 0; s < NKS; ++s) { kf[2 * s] = *(LAS const bf16x8*)(sb + kfo + s * 32); kf[2 * s + 1] = *(LAS const bf16x8*)(sb + kfo + 32 * AK_STRIDE + s * 32); }
            s16x4 vf[16];
#pragma unroll
            for (int n = 0; n < 2; ++n)
#pragma unroll
                for (int s2 = 0; s2 < 2; ++s2) {
                    LAS const unsigned char* vp = sb + vfo + (32 * n + 16 * s2) * AV_STRIDE;
                    vf[(n * 2 + s2) * 4 + 0] = vtr(vp); vf[(n * 2 + s2) * 4 + 1] = vtr(vp + 8 * AV_STRIDE); vf[(n * 2 + s2) * 4 + 2] = vtr(vp + 64); vf[(n * 2 + s2) * 4 + 3] = vtr(vp + 8 * AV_STRIDE + 64);
                }
            __builtin_amdgcn_sched_barrier(0);
#pragma unroll
            for (int i = 0; i < 16; ++i) { s0[i] = 0.f; s1[i] = 0.f; }
#pragma unroll
            for (int s = 0; s < NKS; ++s) { s0 = MFMA32(kf[2 * s], qf[s], s0); s1 = MFMA32(kf[2 * s + 1], qf[s], s1); }
            __builtin_amdgcn_sched_barrier(0);
            if (ODD == 0) { ATT_DMA(ti + 2, (ti + 2) & 3); ATT_DMA(ti + 3, (ti + 3) & 3); }
            __builtin_amdgcn_sched_barrier(0);
            const int kbase = kt * 64;
            if constexpr (MODE == 0) {
                if (kbase + 63 > qa) {
                    const int dlt = qsub - kbase - 4 * h;
#pragma unroll
                    for (int i = 0; i < 16; ++i) { const int ci = (i & 3) + 8 * (i >> 2); if (ci > dlt) s0[i] = -1e30f; if (ci + 32 > dlt) s1[i] = -1e30f; }
                }
            } else {
                LAS const float* tb = tab + (qsub - kbase + 128 - 4 * h - 59);
#pragma unroll
                for (int i = 0; i < 16; ++i) { const int ci = (i & 3) + 8 * (i >> 2);
                    s0[i] = __builtin_fmaf(s0[i], cscale, tb[59 - ci]); s1[i] = __builtin_fmaf(s1[i], cscale, tb[27 - ci]); }
            }
            float mxa, mxb;
            if constexpr (MODE == 0) asm volatile("s_nop 15\n\ts_nop 3" : "+v"(s0), "+v"(s1));
            asm("v_max3_f32 %0, %1, %2, %3\n\tv_max3_f32 %0, %0, %4, %5\n\tv_max3_f32 %0, %0, %6, %7\n\tv_max3_f32 %0, %0, %8, %9\n\tv_max3_f32 %0, %0, %10, %11\n\tv_max3_f32 %0, %0, %12, %13\n\tv_max3_f32 %0, %0, %14, %15\n\tv_max3_f32 %0, %0, %16, %16"
                : "=&v"(mxa) : "v"(s0[0]), "v"(s0[1]), "v"(s0[2]), "v"(s0[3]), "v"(s0[4]), "v"(s0[5]), "v"(s0[6]), "v"(s0[7]), "v"(s0[8]), "v"(s0[9]), "v"(s0[10]), "v"(s0[11]), "v"(s0[12]), "v"(s0[13]), "v"(s0[14]), "v"(s0[15]));
            asm("v_max3_f32 %0, %1, %2, %3\n\tv_max3_f32 %0, %0, %4, %5\n\tv_max3_f32 %0, %0, %6, %7\n\tv_max3_f32 %0, %0, %8, %9\n\tv_max3_f32 %0, %0, %10, %11\n\tv_max3_f32 %0, %0, %12, %13\n\tv_max3_f32 %0, %0, %14, %15\n\tv_max3_f32 %0, %0, %16, %16"
                : "=&v"(mxb) : "v"(s1[0]), "v"(s1[1]), "v"(s1[2]), "v"(s1[3]), "v"(s1[4]), "v"(s1[5]), "v"(s1[6]), "v"(s1[7]), "v"(s1[8]), "v"(s1[9]), "v"(s1[10]), "v"(s1[11]), "v"(s1[12]), "v"(s1[13]), "v"(s1[14]), "v"(s1[15]));
            const float mxl = fmaxf(mxa, mxb);
            if (__builtin_amdgcn_ballot_w64((mxl - mrun) * sc > 8.0f) != 0ull) {
                const float mx = fmaxf(mxl, __shfl_xor(mxl, 32));
                const float mn = fmaxf(mrun, mx), alpha = __builtin_amdgcn_exp2f((mrun - mn) * sc); mrun = mn; lrun *= alpha;
#pragma unroll
                for (int i = 0; i < 16; ++i) { o0[i] *= alpha; o1[i] *= alpha; }
            }
            const float nm = -mrun * sc; float ps = 0.f;
#pragma unroll
            for (int i = 0; i < 16; ++i) {
                if constexpr (MODE == 0) { s0[i] = __builtin_amdgcn_exp2f(__builtin_fmaf(s0[i], sc, nm)); s1[i] = __builtin_amdgcn_exp2f(__builtin_fmaf(s1[i], sc, nm)); }
                else { s0[i] = __builtin_amdgcn_exp2f(s0[i] + nm); s1[i] = __builtin_amdgcn_exp2f(s1[i] + nm); }
                ps += s0[i] + s1[i];
            }
            lrun += ps;
            bf16x8 pk[2][2];
            pk[0][0] = __builtin_bit_cast(bf16x8, __builtin_convertvector(__builtin_shufflevector(s0, s0, 0, 1, 2, 3, 4, 5, 6, 7), bf16x8_t));
            pk[0][1] = __builtin_bit_cast(bf16x8, __builtin_convertvector(__builtin_shufflevector(s0, s0, 8, 9, 10, 11, 12, 13, 14, 15), bf16x8_t));
            pk[1][0] = __builtin_bit_cast(bf16x8, __builtin_convertvector(__builtin_shufflevector(s1, s1, 0, 1, 2, 3, 4, 5, 6, 7), bf16x8_t));
            pk[1][1] = __builtin_bit_cast(bf16x8, __builtin_convertvector(__builtin_shufflevector(s1, s1, 8, 9, 10, 11, 12, 13, 14, 15), bf16x8_t));
#pragma unroll
            for (int n = 0; n < 2; ++n)
#pragma unroll
                for (int s2 = 0; s2 < 2; ++s2) {
                    const int b4 = (n * 2 + s2) * 4;
                    const bf16x8 v0 = __builtin_shufflevector(vf[b4], vf[b4 + 1], 0, 1, 2, 3, 4, 5, 6, 7), v1 = __builtin_shufflevector(vf[b4 + 2], vf[b4 + 3], 0, 1, 2, 3, 4, 5, 6, 7);
                    o0 = MFMA32(v0, pk[n][s2], o0); o1 = MFMA32(v1, pk[n][s2], o1);
                }
        }
        if (ODD) { asm volatile("s_waitcnt vmcnt(0) lgkmcnt(0)" ::: "memory"); __builtin_amdgcn_s_barrier(); asm volatile("" ::: "memory"); }
    };
#pragma unroll 1
    for (int kt = kt_lo; kt <= kt_hi; kt += 2) {
        tile_body(AttTag<0>{}, kt);
        tile_body(AttTag<1>{}, kt + 1);
    }
#undef ATT_DMA
#undef ATT_ACT
#undef ATT_QK
#undef ATT_SM1
#undef ATT_SM2
    const float ltot = lrun + __shfl_xor(lrun, 32), inv = 1.0f / ltot;
    bf16_t* op = Op + qtok * ldo;
#pragma unroll
    for (int g4 = 0; g4 < 4; ++g4) {
        u32x2 w0, w1;
        w0.x = cvt_pk_bf16(o0[4 * g4] * inv, o0[4 * g4 + 1] * inv); w0.y = cvt_pk_bf16(o0[4 * g4 + 2] * inv, o0[4 * g4 + 3] * inv);
        w1.x = cvt_pk_bf16(o1[4 * g4] * inv, o1[4 * g4 + 1] * inv); w1.y = cvt_pk_bf16(o1[4 * g4 + 2] * inv, o1[4 * g4 + 3] * inv);
        *(u32x2*)(op + 8 * g4 + 4 * h) = w0; *(u32x2*)(op + 32 + 8 * g4 + 4 * h) = w1;
    }
    if (MODE == 1 && lse_out != nullptr && h == 0) lse_out[qtok * ld_lse] = (mrun + __builtin_amdgcn_logf(ltot)) * LN2;
}

__constant__ float c_rope_inv[16] = {1.0f, 0.5623413324356079f, 0.3162277638912201f, 0.17782793939113617f, 0.10000000149011612f, 0.05623413249850273f, 0.03162277489900589f,
    0.017782794311642647f, 0.009999999776482582f, 0.005623413249850273f, 0.003162277629598975f, 0.0017782794311642647f, 0.0010000000474974513f, 0.000562341301701963f,
    0.0003162277571391314f, 0.00017782794020604342f};

struct Job { const float* src; bf16_t* dst; const float* gain; int K, N, Npad; };
DI Job get_job(const Params& p, int j) {
    bf16_t* wb = (bf16_t*)(p.ws + WS_W); Job J;
    if (j < 2)       { const int e = j;      J = Job{p.in[5] + (size_t)e * 1024 * 3072, wb + W_IN + (size_t)e * 3145728, p.in[2] + (size_t)(2 * e) * 1024, 1024, 3072, 3072}; }
    else if (j < 4)  { const int e = j - 2;  J = Job{p.in[7] + (size_t)e * 768 * 1024, wb + W_OUT + (size_t)e * 786432, nullptr, 768, 1024, 1024}; }
    else if (j < 6)  { const int o = j - 4;  J = Job{p.in[8] + (size_t)o * 1024 * 672, wb + W_DC + (size_t)o * 786432, p.in[2] + (size_t)(2 * o + 1) * 1024, 1024, 672, 768}; }
    else if (j < 8)  { const int o = j - 6;  J = Job{p.in[10] + (size_t)o * 384 * 768, wb + W_UQ + (size_t)o * 294912, p.in[9] + (size_t)o * 384, 384, 768, 768}; }
    else if (j < 10) { const int o = j - 8;  J = Job{p.in[12] + (size_t)o * 256 * 1024, wb + W_UKV + (size_t)o * 262144, p.in[11] + (size_t)o * 256, 256, 1024, 1024}; }
    else if (j < 12) { const int o = j - 10; J = Job{p.in[13] + (size_t)o * 512 * 1024, wb + W_O + (size_t)o * 524288, nullptr, 512, 1024, 1024}; }
    else if (j < 16) { const int l = j - 12; J = Job{p.in[14] + (size_t)l * 1024 * 4096, wb + W_UP + (size_t)l * 4194304, p.in[3] + (size_t)l * 1024, 1024, 4096, 4096}; }
    else             { const int l = j - 16; J = Job{p.in[15] + (size_t)l * 4096 * 1024, wb + W_DN + (size_t)l * 4194304, nullptr, 4096, 1024, 1024}; }
    return J;
}

DI int t5_bucket(int n) {
    if (n < 16) return n;
    const float nf = (float)n;
    int large = 16 + (int)(__logf(nf / 16.0f) / 4.852030263919617f * 16.0f);
    return large < 31 ? large : 31;
}

DI void prologue(const Params& p, LAS unsigned char* lds) {
    const int tid = opaque_tid(), G = gridDim.x, bid = blockIdx.x;
    {
        const int gw = bid * 8 + (tid >> 6), GW = G * 8, lane = tid & 63;
        int base = 0;
#pragma unroll 1
        for (int j = 0; j < 20; ++j) {
            const Job J = get_job(p, j);
            const int nnb = J.Npad / 256, items = (J.K / 8) * nnb;
#pragma unroll 1
            for (int it = (gw - (base % GW) + GW) % GW; it < items; it += GW) {
                const int kc = it / nnb, nb = it - kc * nnb, n = nb * 256 + lane * 4, k0 = kc * 8;
                f32x4 v[8];
                if (n < J.N) {
#pragma unroll
                    for (int q = 0; q < 8; ++q) v[q] = *(const f32x4*)(J.src + (size_t)(k0 + q) * J.N + n);
                    if (J.gain) {
                        const f32x4 g0 = *(const f32x4*)(J.gain + k0), g1 = *(const f32x4*)(J.gain + k0 + 4);
                        v[0] *= g0[0]; v[1] *= g0[1]; v[2] *= g0[2]; v[3] *= g0[3]; v[4] *= g1[0]; v[5] *= g1[1]; v[6] *= g1[2]; v[7] *= g1[3];
                    }
                } else {
#pragma unroll
                    for (int q = 0; q < 8; ++q) v[q] = (f32x4){0.f, 0.f, 0.f, 0.f};
                }
#pragma unroll
                for (int e = 0; e < 4; ++e) {
                    u32x4 w; w.x = cvt_pk_bf16(v[0][e], v[1][e]); w.y = cvt_pk_bf16(v[2][e], v[3][e]); w.z = cvt_pk_bf16(v[4][e], v[5][e]); w.w = cvt_pk_bf16(v[6][e], v[7][e]);
                    *(u32x4*)(J.dst + (size_t)(n + e) * J.K + k0) = w;
                }
            }
            base += items;
        }
    }
    {
        const float* x = p.in[0]; bf16_t* hb = (bf16_t*)(p.ws + WS_HB); float* partH = (float*)(p.ws + WS_PARTH);
        const int wid = tid >> 6, lane = tid & 63;
        for (int row0 = (bid * 8 + wid) * 2; row0 < T_TOK; row0 += G * 16) {
            f32x4 v[2][4];
#pragma unroll
            for (int r = 0; r < 2; ++r)
#pragma unroll
                for (int i = 0; i < 4; ++i) v[r][i] = *(const f32x4*)(x + (size_t)(row0 + r) * DM + i * 256 + lane * 4);
#pragma unroll
            for (int r = 0; r < 2; ++r) {
                float ss = 0.f;
#pragma unroll
                for (int i = 0; i < 4; ++i) {
                    const f32x4 t = v[r][i];
                    ss += (t[0] * t[0] + t[1] * t[1]) + (t[2] * t[2] + t[3] * t[3]);
                    u32x2 w; w.x = cvt_pk_bf16(t[0], t[1]); w.y = cvt_pk_bf16(t[2], t[3]);
                    *(u32x2*)(hb + (size_t)(row0 + r) * DM + i * 256 + lane * 4) = w;
                }
#pragma unroll
                for (int o = 32; o > 0; o >>= 1) ss += __shfl_xor(ss, o);
                if (lane < 4) partH[(size_t)(row0 + r) * 4 + lane] = (lane == 0) ? ss : 0.f;
            }
        }
    }
    {
        float* cs = (float*)(p.ws + WS_ROPE);
        for (int idx = bid * 512 + tid; idx < SEQ * 16; idx += G * 512) {
            const int pos = idx >> 4, i = idx & 15;
            const float ang = (float)pos * c_rope_inv[i];
            double rv = (double)ang * 0.15915494309189535; rv -= __builtin_rint(rv);
            const float r = (float)rv;
            cs[2 * idx] = __builtin_amdgcn_cosf(r); cs[2 * idx + 1] = __builtin_amdgcn_sinf(r);
        }
    }
    {
        float* bt = (float*)(p.ws + WS_BIAS); const float* rel = p.in[1];
        for (int idx = bid * 512 + tid; idx < 20 * 512; idx += G * 512) {
            const int hd = idx >> 9, dist = (idx & 511) - 128;
            int dl = 1, W = 127;
            if (hd >= 8) { const int g = (hd - 8) >> 2; dl = (g == 0) ? 1 : (g == 1 ? 4 : 16); W = 128; }
            float v = -1e30f;
            if (dist >= 0 && dist <= W) v = rel[t5_bucket(dist * dl) * 20 + hd] * LOG2E;
            bt[idx] = v;
        }
    }
}

extern __shared__ __attribute__((aligned(16))) unsigned char smem_raw[];

struct GDesc { pg8::Gemm g; pg8::Epi E; };
DI GDesc get_gemm(const Params& p, int layer, int slot, int gi) {
    unsigned char* ws = p.ws;
    bf16_t* hb = (bf16_t*)(ws + WS_HB); bf16_t* wb = (bf16_t*)(ws + WS_W);
    float* partH = (float*)(ws + WS_PARTH); float* partO = (float*)(ws + WS_PARTO);
    bf16_t* att = (bf16_t*)(ws + WS_R + R_ATT);
    const int even = (layer & 1) == 0, li = layer >> 1;
    GDesc d;
    const float* rstd = (const float*)(ws + WS_RSTD);
    d.E.mode = 0; d.E.rstd = partH; d.E.rs4 = 1; d.E.relu2 = 0; d.E.part_out = nullptr; d.E.O = hb; d.E.ldo = DM;
    d.g.M = T_TOK;
    if (slot == 0) {
        if (even) { d.g.A = hb; d.g.lda = DM; d.g.Bt = wb + W_IN + (size_t)li * 3145728; d.g.N = 3072; d.g.K = 1024; d.E.O = (bf16_t*)(ws + WS_R + R_PROJ); d.E.ldo = 3072; }
        else      { d.g.A = hb; d.g.lda = DM; d.g.Bt = wb + W_DC + (size_t)li * 786432; d.g.N = 768; d.g.K = 1024; d.E.O = (bf16_t*)(ws + WS_R + R_DOWN); d.E.ldo = 768; d.E.part_out = partO; }
    } else if (slot == 1) {
        bf16_t* down = (bf16_t*)(ws + WS_R + R_DOWN);
        if (gi == 0) { d.g.A = down; d.g.lda = 768; d.g.Bt = wb + W_UQ + (size_t)li * 294912; d.g.N = 768; d.g.K = 384; d.E.O = (bf16_t*)(ws + WS_R + R_Q); d.E.ldo = 768; d.E.rstd = rstd + T_TOK; d.E.rs4 = 0; }
        else         { d.g.A = down + 384; d.g.lda = 768; d.g.Bt = wb + W_UKV + (size_t)li * 262144; d.g.N = 1024; d.g.K = 256; d.E.O = (bf16_t*)(ws + WS_R + R_KV); d.E.ldo = 1024; d.E.rstd = rstd + 2 * T_TOK; d.E.rs4 = 0; }
    } else if (slot == 3) {
        d.E.mode = 1; d.E.part_out = partH;
        if (even) { d.g.A = att; d.g.lda = 768; d.g.Bt = wb + W_OUT + (size_t)li * 786432; d.g.N = 1024; d.g.K = 768; }
        else      { d.g.A = att; d.g.lda = 512; d.g.Bt = wb + W_O + (size_t)li * 524288; d.g.N = 1024; d.g.K = 512; }
    } else if (slot == 4) {
        d.g.A = hb; d.g.lda = DM; d.g.Bt = wb + W_UP + (size_t)layer * 4194304; d.g.N = DFF; d.g.K = 1024; d.E.O = (bf16_t*)(ws + WS_R + R_HID); d.E.ldo = DFF; d.E.relu2 = 1;
    } else {
        d.E.mode = 1; d.E.part_out = partH;
        d.g.A = (bf16_t*)(ws + WS_R + R_HID); d.g.lda = DFF; d.g.Bt = wb + W_DN + (size_t)layer * 4194304; d.g.N = 1024; d.g.K = DFF;
    }
    return d;
}

__global__ void __launch_bounds__(512) trunk_fwd(Params p) {
    cg::grid_group grid = cg::this_grid();
    LAS unsigned char* lds = (LAS unsigned char*)smem_raw;
    const int G = gridDim.x, bid = blockIdx.x;

    volatile LAS unsigned* xst = (volatile LAS unsigned*)(lds + LDS_MAIN);
    if (threadIdx.x < 2) xst[threadIdx.x] = 0u;
    __syncthreads();
    const XcdBarrier xb = xcd_barrier_post((unsigned*)(p.ws + WS_BAR), xst);
#pragma unroll 1
    for (int rep = 0; rep < REP_P0; ++rep) prologue(p, lds);
    grid.sync();

#pragma unroll 1
    for (int layer = 0; layer < 4; ++layer) {
        const int even = (layer & 1) == 0, li = layer >> 1;
#pragma unroll 1
        for (int slot = 0; slot < 6; ++slot) {
            const int ng = (slot == 0 || slot >= 3) ? 1 : ((slot == 1 && !even) ? 2 : 0);
            if (slot == 1 && !even) {
                const int tid = opaque_tid(), j = tid & 7;
                const float* partO = (const float*)(p.ws + WS_PARTO); float* rstd = (float*)(p.ws + WS_RSTD);
                for (int row = bid * 64 + (tid >> 3); row < T_TOK; row += G * 64) {
                    const f32x4 v = *(const f32x4*)(partO + (size_t)row * 32 + j * 4);
                    const float s = (v[0] + v[1]) + (v[2] + v[3]);
                    float sq = (j < 3) ? s : 0.f, sk = (j >= 3 && j < 5) ? s : 0.f;
                    sq += __shfl_xor(sq, 1); sq += __shfl_xor(sq, 2); sq += __shfl_xor(sq, 4);
                    sk += __shfl_xor(sk, 1); sk += __shfl_xor(sk, 2); sk += __shfl_xor(sk, 4);
                    if (j == 0) { rstd[T_TOK + row] = __builtin_amdgcn_rsqf(sq * (1.0f / 384.0f) + EPSN); rstd[2 * T_TOK + row] = __builtin_amdgcn_rsqf(sk * (1.0f / 256.0f) + EPSN); }
                }
                xcd_barrier(xb);
            }
#pragma unroll 1
            for (int gi0 = 0; gi0 < ng * ((slot == 4) ? REP_M1 : 1); ++gi0) {
                const int gi = (slot == 4) ? 0 : gi0;
                const GDesc d = get_gemm(p, layer, slot, gi);
                pg8::StaticOrder S; S.init(d.g.M, d.g.N, G, bid);
                pg8::gemm_phase(lds, d.g, S, d.E);
            }
            unsigned char* ws = p.ws;
            const int tid = opaque_tid();
            if (slot == 1 && even) {
                const bf16_t* proj = (const bf16_t*)(ws + WS_R + R_PROJ);
                bf16_t* att = (bf16_t*)(ws + WS_R + R_ATT);
                bf16_t* obuf = (bf16_t*)(ws + WS_OBUF);
                float* lseb = (float*)(ws + WS_LSE);
                const float* biasT = (const float*)(ws + WS_BIAS);
#pragma unroll 1
                for (int u0 = bid; u0 < 2560 * REP_E2; u0 += G) {
                    const int u = u0 % 2560;
                    int qc, kc, vc, ldo, ld_lse, W, tok0, dl, q0, has_sink, bh; bf16_t* op; float* lp; float sink2 = 0.f;
                    if (u < 1024) {
                        const int b = u >> 9, hq = (u >> 6) & 7, qblk = u & 63, kvh = hq >> 2;
                        qc = hq * 64; kc = 512 + kvh * 64; vc = 640 + kvh * 64; op = att + hq * 64; ldo = 768; lp = nullptr; ld_lse = 0; bh = hq;
                        sink2 = p.in[6][li * 8 + hq] * LOG2E; has_sink = 1; W = 127; tok0 = b * SEQ; dl = 1; q0 = qblk * 256;
                    } else {
                        const int v = u - 1024, g = v >> 9, w = v & 511, b = w >> 8, hbh = (w >> 6) & 3, j = w & 63;
                        dl = (g == 0) ? 1 : (g == 1 ? 4 : 16); const int nqb = 64 / dl, r = j / nqb, qblk = j % nqb;
                        qc = 768 + ((g * 3 + 0) * 4 + hbh) * 64; kc = 768 + ((g * 3 + 1) * 4 + hbh) * 64; vc = 768 + ((g * 3 + 2) * 4 + hbh) * 64;
                        op = obuf + (size_t)g * T_TOK * 256 + hbh * 64; ldo = 256; lp = lseb + (size_t)g * T_TOK * 4 + hbh; ld_lse = 4; bh = 8 + g * 4 + hbh;
                        has_sink = 0; W = 128; tok0 = b * SEQ + r; q0 = qblk * 256;
                    }
                    attn_unit<1>(lds, proj + qc, 3072, proj + kc, 3072, nullptr, proj + vc, 3072, op, ldo, lp, ld_lse,
                                 nullptr, biasT + bh * 512, sink2, has_sink, W, tok0, dl, q0, 0.18033688011112042f);
                }
            } else if (slot == 2 && even) {
                bf16_t* att = (bf16_t*)(ws + WS_R + R_ATT);
                const bf16_t* obuf = (const bf16_t*)(ws + WS_OBUF);
                const float* lseb = (const float*)(ws + WS_LSE);
                for (int idx = bid * 512 + tid; idx < T_TOK * 32; idx += G * 512) {
                    const int tok = idx >> 5, hbh = (idx >> 3) & 3, c = idx & 7;
                    const float l0 = lseb[(size_t)tok * 4 + hbh], l1 = lseb[(size_t)(T_TOK + tok) * 4 + hbh], l2 = lseb[(size_t)(2 * T_TOK + tok) * 4 + hbh];
                    const float mx = fmaxf(l0, fmaxf(l1, l2));
                    float w0 = __expf(l0 - mx), w1 = __expf(l1 - mx), w2 = __expf(l2 - mx);
                    const float inv = 1.0f / (w0 + w1 + w2); w0 *= inv; w1 *= inv; w2 *= inv;
                    const size_t oo = (size_t)tok * 256 + hbh * 64 + c * 8;
                    const u32x4 a = *(const u32x4*)(obuf + oo), b = *(const u32x4*)(obuf + (size_t)T_TOK * 256 + oo), d = *(const u32x4*)(obuf + (size_t)2 * T_TOK * 256 + oo);
                    u32x4 r;
#pragma unroll
                    for (int k = 0; k < 4; ++k)
                        r[k] = cvt_pk_bf16(w0 * bflo(a[k]) + w1 * bflo(b[k]) + w2 * bflo(d[k]), w0 * bfhi(a[k]) + w1 * bfhi(b[k]) + w2 * bfhi(d[k]));
                    *(u32x4*)(att + (size_t)tok * 768 + 512 + hbh * 64 + c * 8) = r;
                }
            } else if (slot == 1 && !even) {
                const bf16_t* down = (const bf16_t*)(ws + WS_R + R_DOWN);
                bf16_t* krope = (bf16_t*)(ws + WS_R + R_KROPE);
                const float* rope_cs = (const float*)(ws + WS_ROPE);
                for (int idx = bid * 512 + tid; idx < T_TOK * 16; idx += G * 512) {
                    const int tok = idx >> 4, i = idx & 15, pos = tok & (SEQ - 1);
                    const float t1 = bf2f(down[(size_t)tok * 768 + 640 + i]), t2 = bf2f(down[(size_t)tok * 768 + 656 + i]);
                    const f32x2 cs = *(const f32x2*)(rope_cs + ((size_t)pos * 16 + i) * 2);
                    krope[(size_t)tok * 32 + i] = (bf16_t)(cvt_pk_bf16(t1 * cs[0] - t2 * cs[1], 0.f) & 0xffffu);
                    krope[(size_t)tok * 32 + 16 + i] = (bf16_t)(cvt_pk_bf16(t1 * cs[1] + t2 * cs[0], 0.f) & 0xffffu);
                }
            } else if (slot == 2 && !even) {
                const bf16_t* qbuf = (const bf16_t*)(ws + WS_R + R_Q);
                const bf16_t* kvb = (const bf16_t*)(ws + WS_R + R_KV);
                const bf16_t* krope = (const bf16_t*)(ws + WS_R + R_KROPE);
                bf16_t* att = (bf16_t*)(ws + WS_R + R_ATT);
                const float* rope_cs = (const float*)(ws + WS_ROPE);
                const int vbid = (G == 256) ? ((bid & 7) * 32 + (bid >> 3)) : bid;
#pragma unroll 1
                for (int it0 = vbid; it0 < 1024 * REP_O3; it0 += G) {
                    const int it = it0 % 1024;
                    const int half = it / 512, pr = it % 512;
                    const int bh = pr >> 5, x = pr & 31, b = bh >> 3, hh = bh & 7;
                    const int qblk = half == 0 ? 63 - x : x;
                    attn_unit<0>(lds, qbuf + hh * 96, 768, kvb + hh * 128, 1024, krope, kvb + hh * 128 + 64, 1024, att + hh * 64, 512, nullptr, 0,
                                 rope_cs, nullptr, 0.f, 0, 0, b * SEQ, 1, qblk * 256, 0.14724444602590306f);
                }
            }
            for (int rs_ = 0; rs_ < REP_SYNC; ++rs_) xcd_barrier(xb);
        }
    }
    {
        const float* fn = p.in[4]; float* outp = p.out; const float* partH = (const float*)(p.ws + WS_PARTH); const bf16_t* hb = (const bf16_t*)(p.ws + WS_HB);
        const int tid = opaque_tid(), wid = tid >> 6, lane = tid & 63;
        for (int row = bid * 8 + wid; row < T_TOK; row += G * 8) {
            const f32x4 pa = *(const f32x4*)(partH + (size_t)row * 4);
            const float ss = (pa[0] + pa[1]) + (pa[2] + pa[3]);
            const float rs = __builtin_amdgcn_rsqf(ss * (1.0f / 1024.0f) + EPSN);
#pragma unroll
            for (int i = 0; i < 2; ++i) {
                const size_t o = (size_t)row * DM + i * 512 + lane * 8;
                const u32x4 r = *(const u32x4*)(hb + o);
                const f32x4 g0 = *(const f32x4*)(fn + i * 512 + lane * 8), g1 = *(const f32x4*)(fn + i * 512 + lane * 8 + 4);
                f32x4 v0, v1;
                v0[0] = bflo(r.x) * rs * g0[0]; v0[1] = bfhi(r.x) * rs * g0[1]; v0[2] = bflo(r.y) * rs * g0[2]; v0[3] = bfhi(r.y) * rs * g0[3];
                v1[0] = bflo(r.z) * rs * g1[0]; v1[1] = bfhi(r.z) * rs * g1[1]; v1[2] = bflo(r.w) * rs * g1[2]; v1[3] = bfhi(r.w) * rs * g1[3];
                *(f32x4*)(outp + o) = v0; *(f32x4*)(outp + o + 4) = v1;
            }
        }
    }
}

extern "C" void kernel_launch(void* const* d_in, const int* in_sizes, int n_in, void* d_out, int out_size, void* d_ws, size_t ws_size, hipStream_t stream) {
    static int grid_blocks = 0;
    if (grid_blocks == 0) {
        if (n_in != 16 || out_size != T_TOK * DM || ws_size < WS_END) { fprintf(stderr, "kernel_launch: unexpected shapes (n_in %d out %d ws %zu)\n", n_in, out_size, ws_size); grid_blocks = -1; return; }
        int dev = 0, cus = 0, per_cu = 0;
        hipGetDevice(&dev);
        hipDeviceGetAttribute(&cus, hipDeviceAttributeMultiprocessorCount, dev);
        if (hipFuncSetAttribute((const void*)trunk_fwd, hipFuncAttributeMaxDynamicSharedMemorySize, LDS_BYTES) != hipSuccess) { fprintf(stderr, "kernel_launch: hipFuncSetAttribute failed\n"); grid_blocks = -1; return; }
        if (hipOccupancyMaxActiveBlocksPerMultiprocessor(&per_cu, (const void*)trunk_fwd, 512, LDS_BYTES) != hipSuccess || per_cu < 1) { fprintf(stderr, "kernel_launch: occupancy query gave %d\n", per_cu); per_cu = 1; }
        (void)hipGetLastError();
        grid_blocks = cus * 1;
    }
    if (grid_blocks < 0) return;
    if (hipMemsetAsync((char*)d_ws + WS_BAR, 0, XCD_BAR_WORDS * sizeof(unsigned), stream) != hipSuccess) { fprintf(stderr, "kernel_launch: memset of barrier words failed\n"); return; }
    Params p{};
    for (int i = 0; i < 16; ++i) p.in[i] = (const float*)d_in[i];
    p.out = (float*)d_out; p.ws = (unsigned char*)d_ws;
    void* args[] = {&p};
    hipError_t e = hipLaunchCooperativeKernel((const void*)trunk_fwd, dim3(grid_blocks), dim3(512), args, LDS_BYTES, stream);
    if (e != hipSuccess) fprintf(stderr, "cooperative launch failed: %s (grid %d)\n", hipGetErrorString(e), grid_blocks);
}
```

```cpp
#include <hip/hip_runtime.h>
#include <hip/hip_cooperative_groups.h>
#include <cstdio>
#include <cstdint>
namespace cg = cooperative_groups;

#define LAS __attribute__((address_space(3)))
#define DI __device__ __forceinline__
typedef unsigned short bf16_t;
typedef short bf16x8 __attribute__((ext_vector_type(8)));
typedef short s16x4 __attribute__((ext_vector_type(4)));
typedef float f32x4 __attribute__((ext_vector_type(4)));
typedef float f32x2 __attribute__((ext_vector_type(2)));
typedef float f32x16 __attribute__((ext_vector_type(16)));
typedef unsigned u32x4 __attribute__((ext_vector_type(4)));
typedef unsigned u32x2 __attribute__((ext_vector_type(2)));

constexpr int T_TOK = 32768, SEQ = 16384, DM = 1024, DFF = 4096;
constexpr float LOG2E = 1.4426950408889634f, LN2 = 0.6931471805599453f, EPSN = 1e-6f;
constexpr size_t MiB = 1u << 20;
constexpr size_t WS_HB = 0, WS_R = 64 * MiB, WS_OBUF = 320 * MiB, WS_W = 368 * MiB, WS_PARTH = 456 * MiB, WS_PARTO = 458 * MiB,
                 WS_ROPE = 462 * MiB, WS_LSE = 464 * MiB, WS_BIAS = 466 * MiB, WS_BAR = 467 * MiB, WS_RSTD = 468 * MiB, WS_END = 469 * MiB;
constexpr size_t R_PROJ = 0, R_ATT = 192 * MiB, R_DOWN = 0, R_Q = 48 * MiB, R_KV = 96 * MiB, R_KROPE = 160 * MiB, R_HID = 0;
constexpr size_t W_IN = 0, W_OUT = 6291456, W_DC = 7864320, W_UQ = 9437184, W_UKV = 10027008, W_O = 10551296, W_UP = 11599872, W_DN = 28377088;
constexpr int LDS_MAIN = 131072, LDS_RS = LDS_MAIN + 16, LDS_BYTES = LDS_RS + 16384;

#ifndef REP_SYNC
#define REP_SYNC 1
#endif
#ifndef REP_P0
#define REP_P0 1
#endif
#ifndef REP_O3
#define REP_O3 1
#endif
#ifndef REP_E2
#define REP_E2 1
#endif
#ifndef REP_M1
#define REP_M1 1
#endif
struct Params { const float* in[16]; float* out; unsigned char* ws; };

typedef __bf16 bf16x2_t __attribute__((ext_vector_type(2)));
typedef __bf16 bf16x8_t __attribute__((ext_vector_type(8)));
DI unsigned cvt_pk_bf16_mm(float lo, float hi) { const f32x2 v = {lo, hi}; return __builtin_bit_cast(unsigned, __builtin_convertvector(v, bf16x2_t)); }
DI unsigned cvt_pk_bf16(float lo, float hi) { unsigned r; asm("v_cvt_pk_bf16_f32 %0, %1, %2" : "=v"(r) : "v"(lo), "v"(hi)); return r; }
DI int opaque_tid() { int t = threadIdx.x; asm volatile("" : "+v"(t)); return t; }
DI float bf2f(bf16_t v) { return __uint_as_float(((unsigned)v) << 16); }
DI float bflo(unsigned u) { return __uint_as_float(u << 16); }
DI float bfhi(unsigned u) { return __uint_as_float(u & 0xffff0000u); }


#define XB_TMO      128
#define XB_XCNT(j)  (256  + 64 * (j))
#define XB_XSUB(j)  (1280 + 64 * (j))
#define XB_XGEN(j)  (2304 + 64 * (j))
#define XB_TOP      3328
#define XB_TOPGEN   3392
#define XCD_BAR_WORDS 3456
#define XB_SPIN_CAP (1u << 18)
DI unsigned xb_ld(unsigned* p)              { return __hip_atomic_load(p, __ATOMIC_RELAXED, __HIP_MEMORY_SCOPE_AGENT); }
DI unsigned xb_add(unsigned* p, unsigned v) { return __hip_atomic_fetch_add(p, v, __ATOMIC_RELAXED, __HIP_MEMORY_SCOPE_AGENT); }
DI unsigned xb_xcc_id() { return (unsigned)__builtin_amdgcn_s_getreg((3 << 11) | 20) & 0xFu; }
#define XB_SPIN(cond, bar) do { unsigned _sp = 0; while (cond) { __builtin_amdgcn_s_sleep(1); \
    if ((++_sp & 255u) == 0u) { if (xb_ld(&(bar)[XB_TMO])) break; if (_sp > XB_SPIN_CAP) { atomicAdd(&(bar)[XB_TMO], 1u); break; } } } } while (0)
struct XcdBarrier { unsigned* bar; unsigned x; volatile LAS unsigned* st; };
DI XcdBarrier xcd_barrier_post(unsigned* bar, volatile LAS unsigned* st) {
    XcdBarrier b; b.bar = bar; b.x = xb_xcc_id(); b.st = st;
    if (threadIdx.x == 0) (void)xb_add(&bar[XB_XCNT(b.x)], 1u);
    return b;
}
DI void xcd_barrier_complete(unsigned* bar, unsigned x, unsigned& nloc, unsigned& nx) {
    const unsigned G = gridDim.x * gridDim.y * gridDim.z;
    unsigned sum, cnt, mine, sp = 0u;
    for (;;) {
        sum = 0u; cnt = 0u; mine = 0u;
#pragma unroll
        for (unsigned j = 0; j < 16; ++j) { const unsigned c = xb_ld(&bar[XB_XCNT(j)]); sum += c; cnt += (c > 0u) ? 1u : 0u; mine = (j == x) ? c : mine; }
        if (sum == G) break;
        __builtin_amdgcn_s_sleep(1);
        if ((++sp & 255u) == 0u) { if (xb_ld(&bar[XB_TMO])) break; if (sp > XB_SPIN_CAP) { atomicAdd(&bar[XB_TMO], 1u); break; } }
    }
    nloc = mine > 0u ? mine : 1u; nx = cnt > 0u ? cnt : 1u;
}
DI void xcd_barrier(const XcdBarrier& b) {
    asm volatile("s_waitcnt vmcnt(0)" ::: "memory");
    __syncthreads();
    if (threadIdx.x == 0) {
        unsigned* bar = b.bar;
        __builtin_amdgcn_s_waitcnt(0);
        unsigned nloc = b.st[0], nx = b.st[1];
        if (nloc == 0u) { xcd_barrier_complete(bar, b.x, nloc, nx); b.st[0] = nloc; b.st[1] = nx; }
        const unsigned old = xb_add(&bar[XB_XSUB(b.x)], 1u);
        const unsigned gen = old / nloc;
        if (old + 1u == (gen + 1u) * nloc) {
            __builtin_amdgcn_fence(__ATOMIC_RELEASE, "agent");
            asm volatile("s_waitcnt vmcnt(0)" ::: "memory");
            const unsigned og = xb_add(&bar[XB_TOP], 1u);
            const unsigned tg = og / nx;
            if (og + 1u == (tg + 1u) * nx) xb_add(&bar[XB_TOPGEN], 1u);
            else XB_SPIN(xb_ld(&bar[XB_TOPGEN]) == tg, bar);
            __builtin_amdgcn_fence(__ATOMIC_ACQUIRE, "agent");
            xb_add(&bar[XB_XGEN(b.x)], 1u);
            asm volatile("s_waitcnt vmcnt(0)" ::: "memory");
        } else {
            XB_SPIN(xb_ld(&bar[XB_XGEN(b.x)]) == gen, bar);
            __builtin_amdgcn_fence(__ATOMIC_ACQUIRE, "agent");
            asm volatile("s_waitcnt vmcnt(0)" ::: "memory");
        }
    }
    __syncthreads();
}

namespace pg8 {
constexpr int BM = 256, BK = 64, HALF = 128, HTB = HALF * BK * 2, NXCD = 8, WGM = 8;
DI int lds_byte(int r, int c) { const int st = (r >> 4) * 2 + (c >> 5), rr = r & 15, cc = c & 31, ob = rr * 64 + cc * 2; return st * 1024 + (ob ^ (((ob >> 9) & 1) << 5)); }
DI void stage_rc(int b, int& R, int& C) { const int st = b / 1024, sb = b % 1024, swz = sb ^ (((sb >> 9) & 1) << 5); R = (st >> 1) * 16 + swz / 64; C = (st & 1) * 32 + (swz % 64) / 2; }
DI int perm32(int rho) { const int n = rho >> 4, i = rho & 15; return 8 * (i >> 2) + 4 * n + (i & 3); }
struct Unit { int pm, pn; };
struct Gemm { const bf16_t* A; int lda; const bf16_t* Bt; int M, N, K; };
struct StaticOrder {
    int nM, nN, nwg, G, c;
    DI void init(int M, int N, int G_, int c_) { nM = M / BM; nN = N / BM; nwg = nM * nN; G = G_; c = c_; }
    DI bool next(int i, Unit& u) const {
        const long L = (long)i * G + c; if (L >= nwg) return false;
        int wgid = (int)L; { const int q = nwg / NXCD, r = nwg % NXCD, xcd = wgid % NXCD, off = wgid / NXCD; wgid = (xcd < r ? xcd * (q + 1) : r * (q + 1) + (xcd - r) * q) + off; }
        const int nig = WGM * nN, gid = wgid / nig, fm = gid * WGM, gsz = (nM - fm) < WGM ? (nM - fm) : WGM;
        u.pm = fm + ((wgid % nig) % gsz); u.pn = (wgid % nig) / gsz; return true;
    }
};

struct Epi {
    int mode;
    bf16_t* O; int ldo; const float* rstd; int rs4; int relu2; float* part_out;
    template <int RELU2, int PART>
    DI void scale_store(const f32x4 (&acc)[2][2][4][2], const Unit& u, int wr, int wc, int fr, int fq, LAS const float* rsl) const {
            float rsv[2][4];
#pragma unroll
            for (int ai = 0; ai < 2; ++ai)
#pragma unroll
                for (int m = 0; m < 4; ++m) {
                    if (rs4) { const f32x4 v = ((LAS const f32x4*)rsl)[ai * 64 + m * 16 + fr]; rsv[ai][m] = __builtin_amdgcn_rsqf(((v[0] + v[1]) + (v[2] + v[3])) * (1.0f / 1024.0f) + EPSN); }
                    else rsv[ai][m] = rsl[ai * 64 + m * 16 + fr];
                }
#pragma unroll
            for (int ai = 0; ai < 2; ++ai)
#pragma unroll
                for (int m = 0; m < 4; ++m) {
                    const int row = u.pm * BM + ai * HALF + wr * 64 + m * 16 + fr;
                    const float rs = rsv[ai][m];
#pragma unroll
                    for (int bj = 0; bj < 2; ++bj) {
                        const int col = u.pn * BM + bj * HALF + wc * 32 + 8 * fq;
                        f32x4 v0 = acc[ai][bj][m][0] * rs, v1 = acc[ai][bj][m][1] * rs;
                        if (RELU2) {
#pragma unroll
                            for (int e = 0; e < 4; ++e) { const float a = fmaxf(v0[e], 0.f), b = fmaxf(v1[e], 0.f); v0[e] = a * a; v1[e] = b * b; }
                        }
                        u32x4 w; w.x = cvt_pk_bf16(v0[0], v0[1]); w.y = cvt_pk_bf16(v0[2], v0[3]); w.z = cvt_pk_bf16(v1[0], v1[1]); w.w = cvt_pk_bf16(v1[2], v1[3]);
                        *(u32x4*)(O + (size_t)row * ldo + col) = w;
                        if (PART) {
                            float sq = (v0[0] * v0[0] + v0[1] * v0[1]) + (v0[2] * v0[2] + v0[3] * v0[3]) + (v1[0] * v1[0] + v1[1] * v1[1]) + (v1[2] * v1[2] + v1[3] * v1[3]);
                            sq += __shfl_xor(sq, 16); sq += __shfl_xor(sq, 32);
                            if (fq == 0) part_out[(size_t)row * 32 + u.pn * 8 + bj * 4 + wc] = sq;
                        }
                    }
                }
    }
    DI void operator()(const f32x4 (&acc)[2][2][4][2], const Unit& u, int wr, int wc, int fr, int fq, LAS const float* rsl, LAS float* red) const {
        if (mode == 0) {
            if (relu2) scale_store<1, 0>(acc, u, wr, wc, fr, fq, rsl);
            else if (part_out) scale_store<0, 1>(acc, u, wr, wc, fr, fq, rsl);
            else scale_store<0, 0>(acc, u, wr, wc, fr, fq, rsl);
        } else {
#pragma unroll
            for (int ai = 0; ai < 2; ++ai) {
                u32x4 rr[4][2];
#pragma unroll
                for (int m = 0; m < 4; ++m)
#pragma unroll
                    for (int bj = 0; bj < 2; ++bj)
                        rr[m][bj] = *(const u32x4*)(O + (size_t)(u.pm * BM + ai * HALF + wr * 64 + m * 16 + fr) * DM + u.pn * BM + bj * HALF + wc * 32 + 8 * fq);
#pragma unroll
                for (int m = 0; m < 4; ++m) {
                    const int row = u.pm * BM + ai * HALF + wr * 64 + m * 16 + fr; float ss = 0.f;
#pragma unroll
                    for (int bj = 0; bj < 2; ++bj) {
                        const int col = u.pn * BM + bj * HALF + wc * 32 + 8 * fq;
                        const size_t o = (size_t)row * DM + col;
                        const u32x4 r = rr[m][bj];
                        f32x4 v0 = acc[ai][bj][m][0], v1 = acc[ai][bj][m][1];
                        v0[0] += bflo(r.x); v0[1] += bfhi(r.x); v0[2] += bflo(r.y); v0[3] += bfhi(r.y); v1[0] += bflo(r.z); v1[1] += bfhi(r.z); v1[2] += bflo(r.w); v1[3] += bfhi(r.w);
                        u32x4 w; w.x = cvt_pk_bf16(v0[0], v0[1]); w.y = cvt_pk_bf16(v0[2], v0[3]); w.z = cvt_pk_bf16(v1[0], v1[1]); w.w = cvt_pk_bf16(v1[2], v1[3]);
                        *(u32x4*)(O + o) = w;
                        ss += (v0[0] * v0[0] + v0[1] * v0[1]) + (v0[2] * v0[2] + v0[3] * v0[3]) + (v1[0] * v1[0] + v1[1] * v1[1]) + (v1[2] * v1[2] + v1[3] * v1[3]);
                    }
                    ss += __shfl_xor(ss, 16); ss += __shfl_xor(ss, 32);
                    if (fq == 0) red[(((wr * 4 + wc) * 8) + ai * 4 + m) * 16 + fr] = ss;
                }
            }
            asm volatile("s_waitcnt lgkmcnt(0)" ::: "memory"); __builtin_amdgcn_s_barrier(); asm volatile("" ::: "memory");
            const int lane = fq * 16 + fr;
            if (lane < 32) {
                const int q = 2 * wc + (lane >> 4), f2 = lane & 15;
                float t = 0.f;
#pragma unroll
                for (int w2 = 0; w2 < 4; ++w2) t += red[(((wr * 4 + w2) * 8) + q) * 16 + f2];
                const int row = u.pm * BM + (q >> 2) * HALF + wr * 64 + (q & 3) * 16 + f2;
                part_out[(size_t)row * 4 + u.pn] = t;
            }
        }
    }
};

DI void gemm_phase(LAS unsigned char* lds, const Gemm g, const StaticOrder& S, const Epi& E) {
    const int tid = opaque_tid(), wid = __builtin_amdgcn_readfirstlane(tid >> 6), lane = tid & 63, wr = wid >> 2, wc = wid & 3, fr = lane & 15, fq = lane >> 4;
    const int K = g.K, nt = K / BK, lda = g.lda;
    unsigned voffA[2], voffB[2];
#pragma unroll
    for (int i = 0; i < 2; ++i) { int R, C; stage_rc(tid * 16 + i * 8192, R, C); const int Rb = (R & ~31) + perm32(R & 31);
        voffA[i] = (unsigned)(R * lda + C) * 2u; voffB[i] = (unsigned)(Rb * K + C) * 2u; }
    const size_t kstep = (size_t)(BK * 2);
    const size_t hstepA = (size_t)HALF * lda * 2, hstepB = (size_t)HALF * K * 2;
    const size_t tstepA = 2 * hstepA, tstepB = 2 * hstepB;
    const unsigned ldsw = (unsigned)wid * 1024u;
    const int aoff = lds_byte(wr * 64 + fr, fq * 8), boff = lds_byte(wc * 32 + fr, fq * 8);
#define PG8_SA(b, h) (((b) * 2 + (h)) * HTB)
#define PG8_SB(b, h) ((4 + (b) * 2 + (h)) * HTB)
#define PG8_STAGE(bufoff, gbase, voff) do { _Pragma("unroll") for (int _i = 0; _i < 2; ++_i) \
        __builtin_amdgcn_global_load_lds((const unsigned*)((const char*)(gbase) + (voff)[_i]), (LAS unsigned*)(lds + (bufoff) + ldsw + _i * 8192), 16, 0, 0); } while (0)
#define PG8_LDA(dst, b, h) do { _Pragma("unroll") for (int m = 0; m < 4; ++m) _Pragma("unroll") for (int k = 0; k < 2; ++k) dst[m][k] = *(const LAS bf16x8*)(lds + PG8_SA(b, h) + aoff + m * 2048 + k * 1024); } while (0)
#define PG8_LDB(dst, b, h) do { _Pragma("unroll") for (int n = 0; n < 2; ++n) _Pragma("unroll") for (int k = 0; k < 2; ++k) dst[n][k] = *(const LAS bf16x8*)(lds + PG8_SB(b, h) + boff + n * 2048 + k * 1024); } while (0)
#define PG8_MMA(ai, bj, At, Bt) do { __builtin_amdgcn_s_setprio(1); _Pragma("unroll") for (int m = 0; m < 4; ++m) _Pragma("unroll") for (int n = 0; n < 2; ++n) _Pragma("unroll") for (int k = 0; k < 2; ++k) \
        acc[ai][bj][m][n] = __builtin_amdgcn_mfma_f32_16x16x32_bf16(Bt[n][k], At[m][k], acc[ai][bj][m][n], 0, 0, 0); __builtin_amdgcn_s_setprio(0); } while (0)
#define PG8_WAIT_V(n) asm volatile("s_waitcnt vmcnt(" #n ")" ::: "memory")
#define PG8_WAIT_L(n) asm volatile("s_waitcnt lgkmcnt(" #n ")" ::: "memory")
#define PG8_BAR __builtin_amdgcn_s_barrier()
#define PG8_SCHED __builtin_amdgcn_sched_barrier(0)
    Unit cur, nxt; int ui = 0;
    if (!S.next(0, cur)) return;
    f32x4 acc[2][2][4][2];
#pragma unroll
    for (int a = 0; a < 2; ++a)
#pragma unroll
        for (int b = 0; b < 2; ++b)
#pragma unroll
            for (int m = 0; m < 4; ++m)
#pragma unroll
                for (int n = 0; n < 2; ++n) acc[a][b][m][n] = (f32x4){0.f, 0.f, 0.f, 0.f};
    bf16x8 At[4][2], B0[2][2], B1[2][2];
    const char* cA = (const char*)g.A + (size_t)cur.pm * tstepA; const char* cB = (const char*)g.Bt + (size_t)cur.pn * tstepB;
    LAS float* rsl = (LAS float*)(lds + LDS_RS) + wid * 512;
#define PG8_RS_DMA(u_) do { if (E.mode == 0) { if (E.rs4) { _Pragma("unroll") for (int ai_ = 0; ai_ < 2; ++ai_) \
            __builtin_amdgcn_global_load_lds((const unsigned*)(E.rstd + (size_t)((u_).pm * BM + ai_ * HALF + wr * 64 + lane) * 4), (LAS unsigned*)(rsl + ai_ * 256), 16, 0, 0); } \
        else { _Pragma("unroll") for (int ai_ = 0; ai_ < 2; ++ai_) \
            __builtin_amdgcn_global_load_lds((const unsigned*)(E.rstd + (u_).pm * BM + ai_ * HALF + wr * 64 + lane), (LAS unsigned*)(rsl + ai_ * 64), 4, 0, 0); } } } while (0)
    PG8_RS_DMA(cur);
    PG8_STAGE(PG8_SB(0, 0), cB, voffB); PG8_STAGE(PG8_SB(0, 1), cB + hstepB, voffB); PG8_STAGE(PG8_SA(0, 0), cA, voffA); PG8_STAGE(PG8_SA(0, 1), cA + hstepA, voffA);
    if (wr == 1) PG8_BAR;
    PG8_WAIT_V(2); PG8_BAR;
    PG8_STAGE(PG8_SB(1, 0), cB + kstep, voffB); PG8_STAGE(PG8_SA(1, 0), cA + kstep, voffA); PG8_STAGE(PG8_SB(1, 1), cB + hstepB + kstep, voffB);
    PG8_WAIT_V(6); PG8_BAR;
    for (;;) {
        const bool has_next = S.next(ui + 1, nxt);
        const char* nA = has_next ? (const char*)g.A + (size_t)nxt.pm * tstepA : cA; const char* nB = has_next ? (const char*)g.Bt + (size_t)nxt.pn * tstepB : cB;
        for (int t = 0; t < nt; t += 2) {
            const bool last = (t == nt - 2);
            const char* a1 = cA + (size_t)(t + 1) * kstep;
            const char* a2 = last ? nA : cA + (size_t)(t + 2) * kstep; const char* b2 = last ? nB : cB + (size_t)(t + 2) * kstep;
            const char* a3 = a2 + kstep; const char* b3 = b2 + kstep;
            PG8_LDB(B0, 0, 0); PG8_LDB(B1, 0, 1); PG8_SCHED; PG8_LDA(At, 0, 0); PG8_STAGE(PG8_SA(1, 1), a1 + hstepA, voffA);
            PG8_WAIT_V(8); PG8_WAIT_L(0); PG8_BAR; PG8_MMA(0, 0, At, B0); PG8_MMA(0, 1, At, B1); PG8_BAR; PG8_SCHED;
            PG8_LDA(At, 0, 1); PG8_STAGE(PG8_SB(0, 0), b2, voffB); PG8_STAGE(PG8_SB(0, 1), b2 + hstepB, voffB); PG8_STAGE(PG8_SA(0, 0), a2, voffA);
            PG8_WAIT_V(8); PG8_WAIT_L(0); PG8_BAR; PG8_MMA(1, 0, At, B0); PG8_MMA(1, 1, At, B1); PG8_BAR; PG8_SCHED;
            PG8_LDB(B0, 1, 0); PG8_LDB(B1, 1, 1); PG8_SCHED; PG8_LDA(At, 1, 0); PG8_STAGE(PG8_SA(0, 1), a2 + hstepA, voffA);
            PG8_WAIT_V(8); PG8_WAIT_L(0); PG8_BAR; PG8_MMA(0, 0, At, B0); PG8_MMA(0, 1, At, B1); PG8_BAR; PG8_SCHED;
            PG8_LDA(At, 1, 1); PG8_STAGE(PG8_SB(1, 0), b3, voffB); PG8_STAGE(PG8_SB(1, 1), b3 + hstepB, voffB); PG8_STAGE(PG8_SA(1, 0), a3, voffA);
            PG8_WAIT_V(8); PG8_WAIT_L(0); PG8_BAR; PG8_MMA(1, 0, At, B0); PG8_MMA(1, 1, At, B1); PG8_BAR; PG8_SCHED;
        }
        if (wr == 0) PG8_BAR;
        E(acc, cur, wr, wc, fr, fq, rsl, (LAS float*)(lds + LDS_RS));
        if (!has_next) break;
        PG8_RS_DMA(nxt);
#pragma unroll
        for (int a = 0; a < 2; ++a)
#pragma unroll
            for (int b = 0; b < 2; ++b)
#pragma unroll
                for (int m = 0; m < 4; ++m)
#pragma unroll
                    for (int n = 0; n < 2; ++n) acc[a][b][m][n] = (f32x4){0.f, 0.f, 0.f, 0.f};
        cur = nxt; cA = nA; cB = nB; ++ui;
        if (wr == 1) PG8_BAR;
    }
    PG8_WAIT_V(0);
    PG8_BAR;
#undef PG8_RS_DMA
#undef PG8_SA
#undef PG8_SB
#undef PG8_STAGE
#undef PG8_LDA
#undef PG8_LDB
#undef PG8_MMA
#undef PG8_WAIT_V
#undef PG8_WAIT_L
#undef PG8_BAR
#undef PG8_SCHED
}

}

constexpr int AK_STRIDE = 208, AV_STRIDE = 192, AV_OFF = 64 * AK_STRIDE, A_STAGE = AV_OFF + 64 * AV_STRIDE, A_TAB = 4 * A_STAGE;
DI float max3f(float a, float b, float c) { float r; asm("v_max3_f32 %0, %1, %2, %3" : "=v"(r) : "v"(a), "v"(b), "v"(c)); return r; }
DI int crow(int i, int h) { return (i & 3) + 8 * (i >> 2) + 4 * h; }
#define MFMA32(a, b, c) __builtin_amdgcn_mfma_f32_32x32x16_bf16((a), (b), (c), 0, 0, 0)
typedef short v4i16_t __attribute__((ext_vector_type(4)));
DI s16x4 vtr(LAS const unsigned char* p) { return __builtin_bit_cast(s16x4, __builtin_amdgcn_ds_read_tr16_b64_v4i16((LAS v4i16_t*)p)); }

template <int MODE>
DI void attn_unit(LAS unsigned char* lds, const bf16_t* __restrict__ Qp, int ldq, const bf16_t* __restrict__ Kp, int ldk, const bf16_t* __restrict__ KRp,
                  const bf16_t* __restrict__ Vp, int ldv, bf16_t* __restrict__ Op, int ldo, float* __restrict__ lse_out, int ld_lse,
                  const float* __restrict__ rope_cs, const float* __restrict__ bias_g, float sink2, int has_sink, int W,
                  int tok0, int dil, int q0, float cscale) {
    constexpr int NKS = MODE == 0 ? 6 : 4;
    const int tid = opaque_tid(), wid = __builtin_amdgcn_readfirstlane(tid >> 6), lane = tid & 63, ql = lane & 31, h = lane >> 5;
    __builtin_assume(wid >= 0 && wid < 8);
    const int qa = q0 + 32 * wid, qb = qa + 31, qsub = qa + ql;
    const long qtok = (long)tok0 + (long)qsub * dil;
    bf16x8 qf[NKS];
    {
        const bf16_t* qptr = Qp + qtok * ldq;
#pragma unroll
        for (int s = 0; s < 4; ++s) qf[s] = *(const bf16x8*)(qptr + 16 * s + 8 * h);
        if constexpr (MODE == 0) {
            const u32x4 t1 = *(const u32x4*)(qptr + 64 + 8 * h), t2 = *(const u32x4*)(qptr + 80 + 8 * h);
            const float* cs = rope_cs + ((size_t)qsub * 16 + 8 * h) * 2;
            u32x4 o1, o2;
#pragma unroll
            for (int jj = 0; jj < 4; ++jj) {
                const f32x4 c4 = *(const f32x4*)(cs + 4 * jj);
                const float a0 = bflo(t1[jj]), a1 = bfhi(t1[jj]), b0 = bflo(t2[jj]), b1 = bfhi(t2[jj]);
                o1[jj] = cvt_pk_bf16_mm(a0 * c4[0] - b0 * c4[1], a1 * c4[2] - b1 * c4[3]);
                o2[jj] = cvt_pk_bf16_mm(a0 * c4[1] + b0 * c4[0], a1 * c4[3] + b1 * c4[2]);
            }
            qf[4] = __builtin_bit_cast(bf16x8, o1); qf[5] = __builtin_bit_cast(bf16x8, o2);
        }
    }
    int kt_lo = 0; const int kt_hi = (q0 >> 6) + 3;
    if constexpr (MODE == 1) { kt_lo = (q0 >> 6) - 2; if (kt_lo < 0) kt_lo = 0; }
    const bf16_t* dsrc[4]; unsigned dstr[4];
#pragma unroll
    for (int j = 0; j < 4; ++j) {
        const int c = (wid + 8 * j) * 64 + lane;
        const bf16_t* ptr; long strd;
        if (c < 832) {
            const int row = c / 13, col = c - row * 13;
            if (MODE == 0 && col >= 8 && col < 12) { ptr = KRp + ((long)tok0 + row) * 32 + (col - 8) * 8; strd = (long)64 * 32; }
            else { const int cc = (col < 8) ? col : 0; ptr = Kp + ((long)tok0 + (long)row * dil) * ldk + cc * 8; strd = (long)64 * dil * ldk; }
        } else if (c < 1600) {
            const int c2 = c - 832, row = c2 / 12, col = c2 - row * 12, cc = (col < 8) ? col : 0;
            ptr = Vp + ((long)tok0 + (long)row * dil) * ldv + cc * 8; strd = (long)64 * dil * ldv;
        } else { ptr = Vp + ((long)tok0) * ldv; strd = (long)64 * dil * ldv; }
        dsrc[j] = ptr + (long)kt_lo * strd; dstr[j] = (unsigned)(strd * 2);
    }
    LAS float* tab = (LAS float*)(lds + A_TAB);
    if constexpr (MODE == 1) tab[tid] = bias_g[tid];
#define ATT_DMA(ti_, stg_) do { if ((ti_) <= nt_m1) { \
        _Pragma("unroll") for (int j_ = 0; j_ < 4; ++j_) { const int slot_ = wid + 8 * j_; \
            if (slot_ < 25) { __builtin_amdgcn_global_load_lds((const unsigned*)dsrc[j_], (LAS unsigned*)(lds + (stg_) * A_STAGE + slot_ * 1024), 16, 0, 0); \
                              dsrc[j_] = (const bf16_t*)((const char*)dsrc[j_] + dstr[j_]); } } } } while (0)
    const int nt_m1 = kt_hi - kt_lo;
    ATT_DMA(0, 0); ATT_DMA(1, 1);
    asm volatile("s_waitcnt vmcnt(0)" ::: "memory");
    __syncthreads();
    f32x16 o0, o1;
#pragma unroll
    for (int i = 0; i < 16; ++i) { o0[i] = 0.f; o1[i] = 0.f; }
    float mrun = -1e29f, lrun = 0.f;
    if (has_sink) { mrun = sink2; lrun = (h == 0) ? 1.f : 0.f; }
    const float sc = (MODE == 0) ? cscale : 1.0f;
    const unsigned kfo = ql * AK_STRIDE + h * 16;
    const unsigned vfo = AV_OFF + (4 * h + ((lane & 15) >> 2)) * AV_STRIDE + (16 * ((lane >> 4) & 1) + 4 * (lane & 3)) * 2;

#define ATT_ACT(kt_) (((kt_) <= kt_hi) && ((kt_) * 64 <= qb) && (MODE == 0 || ((kt_) * 64 + 63 >= qa - W)))
    f32x16 s0, s1;
#pragma unroll 1
    for (int kt = kt_lo; kt <= kt_hi; ++kt) {
        const int ti = kt - kt_lo, stg = ti & 3;
        const bool act_t = ATT_ACT(kt);
        if (!act_t && (ti & 1) == 0) { ATT_DMA(ti + 2, (ti + 2) & 3); ATT_DMA(ti + 3, (ti + 3) & 3); }
        if (act_t) {
            LAS const unsigned char* sb = lds + stg * A_STAGE;
            bf16x8 kf[2 * NKS];
#pragma unroll
            for (int s = 0; s < NKS; ++s) { kf[2 * s] = *(LAS const bf16x8*)(sb + kfo + s * 32); kf[2 * s + 1] = *(LAS const bf16x8*)(sb + kfo + 32 * AK_STRIDE + s * 32); }
            s16x4 vf[16];
#pragma unroll
            for (int n = 0; n < 2; ++n)
#pragma unroll
                for (int s2 = 0; s2 < 2; ++s2) {
                    LAS const unsigned char* vp = sb + vfo + (32 * n + 16 * s2) * AV_STRIDE;
                    vf[(n * 2 + s2) * 4 + 0] = vtr(vp); vf[(n * 2 + s2) * 4 + 1] = vtr(vp + 8 * AV_STRIDE); vf[(n * 2 + s2) * 4 + 2] = vtr(vp + 64); vf[(n * 2 + s2) * 4 + 3] = vtr(vp + 8 * AV_STRIDE + 64);
                }
            __builtin_amdgcn_sched_barrier(0);
#pragma unroll
            for (int i = 0; i < 16; ++i) { s0[i] = 0.f; s1[i] = 0.f; }
#pragma unroll
            for (int s = 0; s < NKS; ++s) { s0 = MFMA32(kf[2 * s], qf[s], s0); s1 = MFMA32(kf[2 * s + 1], qf[s], s1); }
            __builtin_amdgcn_sched_barrier(0);
            if ((ti & 1) == 0) { ATT_DMA(ti + 2, (ti + 2) & 3); ATT_DMA(ti + 3, (ti + 3) & 3); }
            __builtin_amdgcn_sched_barrier(0);
            const int kbase = kt * 64;
            if constexpr (MODE == 0) {
                if (kbase + 63 > qa) {
                    const int dlt = qsub - kbase - 4 * h;
#pragma unroll
                    for (int i = 0; i < 16; ++i) { const int ci = (i & 3) + 8 * (i >> 2); if (ci > dlt) s0[i] = -1e30f; if (ci + 32 > dlt) s1[i] = -1e30f; }
                }
            } else {
                LAS const float* tb = tab + (qsub - kbase + 128 - 4 * h - 59);
#pragma unroll
                for (int i = 0; i < 16; ++i) { const int ci = (i & 3) + 8 * (i >> 2);
                    s0[i] = __builtin_fmaf(s0[i], cscale, tb[59 - ci]); s1[i] = __builtin_fmaf(s1[i], cscale, tb[27 - ci]); }
            }
            float mxa, mxb;
            if constexpr (MODE == 0) asm volatile("s_nop 15\n\ts_nop 3" : "+v"(s0), "+v"(s1));
            asm("v_max3_f32 %0, %1, %2, %3\n\tv_max3_f32 %0, %0, %4, %5\n\tv_max3_f32 %0, %0, %6, %7\n\tv_max3_f32 %0, %0, %8, %9\n\tv_max3_f32 %0, %0, %10, %11\n\tv_max3_f32 %0, %0, %12, %13\n\tv_max3_f32 %0, %0, %14, %15\n\tv_max3_f32 %0, %0, %16, %16"
                : "=&v"(mxa) : "v"(s0[0]), "v"(s0[1]), "v"(s0[2]), "v"(s0[3]), "v"(s0[4]), "v"(s0[5]), "v"(s0[6]), "v"(s0[7]), "v"(s0[8]), "v"(s0[9]), "v"(s0[10]), "v"(s0[11]), "v"(s0[12]), "v"(s0[13]), "v"(s0[14]), "v"(s0[15]));
            asm("v_max3_f32 %0, %1, %2, %3\n\tv_max3_f32 %0, %0, %4, %5\n\tv_max3_f32 %0, %0, %6, %7\n\tv_max3_f32 %0, %0, %8, %9\n\tv_max3_f32 %0, %0, %10, %11\n\tv_max3_f32 %0, %0, %12, %13\n\tv_max3_f32 %0, %0, %14, %15\n\tv_max3_f32 %0, %0, %16, %16"
                : "=&v"(mxb) : "v"(s1[0]), "v"(s1[1]), "v"(s1[2]), "v"(s1[3]), "v"(s1[4]), "v"(s1[5]), "v"(s1[6]), "v"(s1[7]), "v"(s1[8]), "v"(s1[9]), "v"(s1[10]), "v"(s1[11]), "v"(s1[12]), "v"(s1[13]), "v"(s1[14]), "v"(s1[15]));
            const float mxl = fmaxf(mxa, mxb);
            if (__builtin_amdgcn_ballot_w64((mxl - mrun) * sc > 8.0f) != 0ull) {
                const float mx = fmaxf(mxl, __shfl_xor(mxl, 32));
                const float mn = fmaxf(mrun, mx), alpha = __builtin_amdgcn_exp2f((mrun - mn) * sc); mrun = mn; lrun *= alpha;
#pragma unroll
                for (int i = 0; i < 16; ++i) { o0[i] *= alpha; o1[i] *= alpha; }
            }
            const float nm = -mrun * sc; float ps = 0.f;
#pragma unroll
            for (int i = 0; i < 16; ++i) {
                if constexpr (MODE == 0) { s0[i] = __builtin_amdgcn_exp2f(__builtin_fmaf(s0[i], sc, nm)); s1[i] = __builtin_amdgcn_exp2f(__builtin_fmaf(s1[i], sc, nm)); }
                else { s0[i] = __builtin_amdgcn_exp2f(s0[i] + nm); s1[i] = __builtin_amdgcn_exp2f(s1[i] + nm); }
                ps += s0[i] + s1[i];
            }
            lrun += ps;
            bf16x8 pk[2][2];
            pk[0][0] = __builtin_bit_cast(bf16x8, __builtin_convertvector(__builtin_shufflevector(s0, s0, 0, 1, 2, 3, 4, 5, 6, 7), bf16x8_t));
            pk[0][1] = __builtin_bit_cast(bf16x8, __builtin_convertvector(__builtin_shufflevector(s0, s0, 8, 9, 10, 11, 12, 13, 14, 15), bf16x8_t));
            pk[1][0] = __builtin_bit_cast(bf16x8, __builtin_convertvector(__builtin_shufflevector(s1, s1, 0, 1, 2, 3, 4, 5, 6, 7), bf16x8_t));
            pk[1][1] = __builtin_bit_cast(bf16x8, __builtin_convertvector(__builtin_shufflevector(s1, s1, 8, 9, 10, 11, 12, 13, 14, 15), bf16x8_t));
#pragma unroll
            for (int n = 0; n < 2; ++n)
#pragma unroll
                for (int s2 = 0; s2 < 2; ++s2) {
                    const int b4 = (n * 2 + s2) * 4;
                    const bf16x8 v0 = __builtin_shufflevector(vf[b4], vf[b4 + 1], 0, 1, 2, 3, 4, 5, 6, 7), v1 = __builtin_shufflevector(vf[b4 + 2], vf[b4 + 3], 0, 1, 2, 3, 4, 5, 6, 7);
                    o0 = MFMA32(v0, pk[n][s2], o0); o1 = MFMA32(v1, pk[n][s2], o1);
                }
        }
        if (ti & 1) { asm volatile("s_waitcnt vmcnt(0) lgkmcnt(0)" ::: "memory"); __builtin_amdgcn_s_barrier(); asm volatile("" ::: "memory"); }
    }
#undef ATT_DMA
#undef ATT_ACT
#undef ATT_QK
#undef ATT_SM1
#undef ATT_SM2
    const float ltot = lrun + __shfl_xor(lrun, 32), inv = 1.0f / ltot;
    bf16_t* op = Op + qtok * ldo;
#pragma unroll
    for (int g4 = 0; g4 < 4; ++g4) {
        u32x2 w0, w1;
        w0.x = cvt_pk_bf16(o0[4 * g4] * inv, o0[4 * g4 + 1] * inv); w0.y = cvt_pk_bf16(o0[4 * g4 + 2] * inv, o0[4 * g4 + 3] * inv);
        w1.x = cvt_pk_bf16(o1[4 * g4] * inv, o1[4 * g4 + 1] * inv); w1.y = cvt_pk_bf16(o1[4 * g4 + 2] * inv, o1[4 * g4 + 3] * inv);
        *(u32x2*)(op + 8 * g4 + 4 * h) = w0; *(u32x2*)(op + 32 + 8 * g4 + 4 * h) = w1;
    }
    if (MODE == 1 && lse_out != nullptr && h == 0) lse_out[qtok * ld_lse] = (mrun + __builtin_amdgcn_logf(ltot)) * LN2;
}

__constant__ float c_rope_inv[16] = {1.0f, 0.5623413324356079f, 0.3162277638912201f, 0.17782793939113617f, 0.10000000149011612f, 0.05623413249850273f, 0.03162277489900589f,
    0.017782794311642647f, 0.009999999776482582f, 0.005623413249850273f, 0.003162277629598975f, 0.0017782794311642647f, 0.0010000000474974513f, 0.000562341301701963f,
    0.0003162277571391314f, 0.00017782794020604342f};

struct Job { const float* src; bf16_t* dst; const float* gain; int K, N, Npad; };
DI Job get_job(const Params& p, int j) {
    bf16_t* wb = (bf16_t*)(p.ws + WS_W); Job J;
    if (j < 2)       { const int e = j;      J = Job{p.in[5] + (size_t)e * 1024 * 3072, wb + W_IN + (size_t)e * 3145728, p.in[2] + (size_t)(2 * e) * 1024, 1024, 3072, 3072}; }
    else if (j < 4)  { const int e = j - 2;  J = Job{p.in[7] + (size_t)e * 768 * 1024, wb + W_OUT + (size_t)e * 786432, nullptr, 768, 1024, 1024}; }
    else if (j < 6)  { const int o = j - 4;  J = Job{p.in[8] + (size_t)o * 1024 * 672, wb + W_DC + (size_t)o * 786432, p.in[2] + (size_t)(2 * o + 1) * 1024, 1024, 672, 768}; }
    else if (j < 8)  { const int o = j - 6;  J = Job{p.in[10] + (size_t)o * 384 * 768, wb + W_UQ + (size_t)o * 294912, p.in[9] + (size_t)o * 384, 384, 768, 768}; }
    else if (j < 10) { const int o = j - 8;  J = Job{p.in[12] + (size_t)o * 256 * 1024, wb + W_UKV + (size_t)o * 262144, p.in[11] + (size_t)o * 256, 256, 1024, 1024}; }
    else if (j < 12) { const int o = j - 10; J = Job{p.in[13] + (size_t)o * 512 * 1024, wb + W_O + (size_t)o * 524288, nullptr, 512, 1024, 1024}; }
    else if (j < 16) { const int l = j - 12; J = Job{p.in[14] + (size_t)l * 1024 * 4096, wb + W_UP + (size_t)l * 4194304, p.in[3] + (size_t)l * 1024, 1024, 4096, 4096}; }
    else             { const int l = j - 16; J = Job{p.in[15] + (size_t)l * 4096 * 1024, wb + W_DN + (size_t)l * 4194304, nullptr, 4096, 1024, 1024}; }
    return J;
}

DI int t5_bucket(int n) {
    if (n < 16) return n;
    const float nf = (float)n;
    int large = 16 + (int)(__logf(nf / 16.0f) / 4.852030263919617f * 16.0f);
    return large < 31 ? large : 31;
}

DI void prologue(const Params& p, LAS unsigned char* lds) {
    const int tid = opaque_tid(), G = gridDim.x, bid = blockIdx.x;
    {
        const int gw = bid * 8 + (tid >> 6), GW = G * 8, lane = tid & 63;
        int base = 0;
#pragma unroll 1
        for (int j = 0; j < 20; ++j) {
            const Job J = get_job(p, j);
            const int nnb = J.Npad / 256, items = (J.K / 8) * nnb;
#pragma unroll 1
            for (int it = (gw - (base % GW) + GW) % GW; it < items; it += GW) {
                const int kc = it / nnb, nb = it - kc * nnb, n = nb * 256 + lane * 4, k0 = kc * 8;
                f32x4 v[8];
                if (n < J.N) {
#pragma unroll
                    for (int q = 0; q < 8; ++q) v[q] = *(const f32x4*)(J.src + (size_t)(k0 + q) * J.N + n);
                    if (J.gain) {
                        const f32x4 g0 = *(const f32x4*)(J.gain + k0), g1 = *(const f32x4*)(J.gain + k0 + 4);
                        v[0] *= g0[0]; v[1] *= g0[1]; v[2] *= g0[2]; v[3] *= g0[3]; v[4] *= g1[0]; v[5] *= g1[1]; v[6] *= g1[2]; v[7] *= g1[3];
                    }
                } else {
#pragma unroll
                    for (int q = 0; q < 8; ++q) v[q] = (f32x4){0.f, 0.f, 0.f, 0.f};
                }
#pragma unroll
                for (int e = 0; e < 4; ++e) {
                    u32x4 w; w.x = cvt_pk_bf16(v[0][e], v[1][e]); w.y = cvt_pk_bf16(v[2][e], v[3][e]); w.z = cvt_pk_bf16(v[4][e], v[5][e]); w.w = cvt_pk_bf16(v[6][e], v[7][e]);
                    *(u32x4*)(J.dst + (size_t)(n + e) * J.K + k0) = w;
                }
            }
            base += items;
        }
    }
    {
        const float* x = p.in[0]; bf16_t* hb = (bf16_t*)(p.ws + WS_HB); float* partH = (float*)(p.ws + WS_PARTH);
        const int wid = tid >> 6, lane = tid & 63;
        for (int row0 = (bid * 8 + wid) * 2; row0 < T_TOK; row0 += G * 16) {
            f32x4 v[2][4];
#pragma unroll
            for (int r = 0; r < 2; ++r)
#pragma unroll
                for (int i = 0; i < 4; ++i) v[r][i] = *(const f32x4*)(x + (size_t)(row0 + r) * DM + i * 256 + lane * 4);
#pragma unroll
            for (int r = 0; r < 2; ++r) {
                float ss = 0.f;
#pragma unroll
                for (int i = 0; i < 4; ++i) {
                    const f32x4 t = v[r][i];
                    ss += (t[0] * t[0] + t[1] * t[1]) + (t[2] * t[2] + t[3] * t[3]);
                    u32x2 w; w.x = cvt_pk_bf16(t[0], t[1]); w.y = cvt_pk_bf16(t[2], t[3]);
                    *(u32x2*)(hb + (size_t)(row0 + r) * DM + i * 256 + lane * 4) = w;
                }
#pragma unroll
                for (int o = 32; o > 0; o >>= 1) ss += __shfl_xor(ss, o);
                if (lane < 4) partH[(size_t)(row0 + r) * 4 + lane] = (lane == 0) ? ss : 0.f;
            }
        }
    }
    {
        float* cs = (float*)(p.ws + WS_ROPE);
        for (int idx = bid * 512 + tid; idx < SEQ * 16; idx += G * 512) {
            const int pos = idx >> 4, i = idx & 15;
            const float ang = (float)pos * c_rope_inv[i];
            double rv = (double)ang * 0.15915494309189535; rv -= __builtin_rint(rv);
            const float r = (float)rv;
            cs[2 * idx] = __builtin_amdgcn_cosf(r); cs[2 * idx + 1] = __builtin_amdgcn_sinf(r);
        }
    }
    {
        float* bt = (float*)(p.ws + WS_BIAS); const float* rel = p.in[1];
        for (int idx = bid * 512 + tid; idx < 20 * 512; idx += G * 512) {
            const int hd = idx >> 9, dist = (idx & 511) - 128;
            int dl = 1, W = 127;
            if (hd >= 8) { const int g = (hd - 8) >> 2; dl = (g == 0) ? 1 : (g == 1 ? 4 : 16); W = 128; }
            float v = -1e30f;
            if (dist >= 0 && dist <= W) v = rel[t5_bucket(dist * dl) * 20 + hd] * LOG2E;
            bt[idx] = v;
        }
    }
}

extern __shared__ __attribute__((aligned(16))) unsigned char smem_raw[];

struct GDesc { pg8::Gemm g; pg8::Epi E; };
DI GDesc get_gemm(const Params& p, int layer, int slot, int gi) {
    unsigned char* ws = p.ws;
    bf16_t* hb = (bf16_t*)(ws + WS_HB); bf16_t* wb = (bf16_t*)(ws + WS_W);
    float* partH = (float*)(ws + WS_PARTH); float* partO = (float*)(ws + WS_PARTO);
    bf16_t* att = (bf16_t*)(ws + WS_R + R_ATT);
    const int even = (layer & 1) == 0, li = layer >> 1;
    GDesc d;
    const float* rstd = (const float*)(ws + WS_RSTD);
    d.E.mode = 0; d.E.rstd = partH; d.E.rs4 = 1; d.E.relu2 = 0; d.E.part_out = nullptr; d.E.O = hb; d.E.ldo = DM;
    d.g.M = T_TOK;
    if (slot == 0) {
        if (even) { d.g.A = hb; d.g.lda = DM; d.g.Bt = wb + W_IN + (size_t)li * 3145728; d.g.N = 3072; d.g.K = 1024; d.E.O = (bf16_t*)(ws + WS_R + R_PROJ); d.E.ldo = 3072; }
        else      { d.g.A = hb; d.g.lda = DM; d.g.Bt = wb + W_DC + (size_t)li * 786432; d.g.N = 768; d.g.K = 1024; d.E.O = (bf16_t*)(ws + WS_R + R_DOWN); d.E.ldo = 768; d.E.part_out = partO; }
    } else if (slot == 1) {
        bf16_t* down = (bf16_t*)(ws + WS_R + R_DOWN);
        if (gi == 0) { d.g.A = down; d.g.lda = 768; d.g.Bt = wb + W_UQ + (size_t)li * 294912; d.g.N = 768; d.g.K = 384; d.E.O = (bf16_t*)(ws + WS_R + R_Q); d.E.ldo = 768; d.E.rstd = rstd + T_TOK; d.E.rs4 = 0; }
        else         { d.g.A = down + 384; d.g.lda = 768; d.g.Bt = wb + W_UKV + (size_t)li * 262144; d.g.N = 1024; d.g.K = 256; d.E.O = (bf16_t*)(ws + WS_R + R_KV); d.E.ldo = 1024; d.E.rstd = rstd + 2 * T_TOK; d.E.rs4 = 0; }
    } else if (slot == 3) {
        d.E.mode = 1; d.E.part_out = partH;
        if (even) { d.g.A = att; d.g.lda = 768; d.g.Bt = wb + W_OUT + (size_t)li * 786432; d.g.N = 1024; d.g.K = 768; }
        else      { d.g.A = att; d.g.lda = 512; d.g.Bt = wb + W_O + (size_t)li * 524288; d.g.N = 1024; d.g.K = 512; }
    } else if (slot == 4) {
        d.g.A = hb; d.g.lda = DM; d.g.Bt = wb + W_UP + (size_t)layer * 4194304; d.g.N = DFF; d.g.K = 1024; d.E.O = (bf16_t*)(ws + WS_R + R_HID); d.E.ldo = DFF; d.E.relu2 = 1;
    } else {
        d.E.mode = 1; d.E.part_out = partH;
        d.g.A = (bf16_t*)(ws + WS_R + R_HID); d.g.lda = DFF; d.g.Bt = wb + W_DN + (size_t)layer * 4194304; d.g.N = 1024; d.g.K = DFF;
    }
    return d;
}

__global__ void __launch_bounds__(512) trunk_fwd(Params p) {
    cg::grid_group grid = cg::this_grid();
    LAS unsigned char* lds = (LAS unsigned char*)smem_raw;
    const int G = gridDim.x, bid = blockIdx.x;

    volatile LAS unsigned* xst = (volatile LAS unsigned*)(lds + LDS_MAIN);
    if (threadIdx.x < 2) xst[threadIdx.x] = 0u;
    __syncthreads();
    const XcdBarrier xb = xcd_barrier_post((unsigned*)(p.ws + WS_BAR), xst);
#pragma unroll 1
    for (int rep = 0; rep < REP_P0; ++rep) prologue(p, lds);
    grid.sync();

#pragma unroll 1
    for (int layer = 0; layer < 4; ++layer) {
        const int even = (layer & 1) == 0, li = layer >> 1;
#pragma unroll 1
        for (int slot = 0; slot < 6; ++slot) {
            const int ng = (slot == 0 || slot >= 3) ? 1 : ((slot == 1 && !even) ? 2 : 0);
            if (slot == 1 && !even) {
                const int tid = opaque_tid(), j = tid & 7;
                const float* partO = (const float*)(p.ws + WS_PARTO); float* rstd = (float*)(p.ws + WS_RSTD);
                for (int row = bid * 64 + (tid >> 3); row < T_TOK; row += G * 64) {
                    const f32x4 v = *(const f32x4*)(partO + (size_t)row * 32 + j * 4);
                    const float s = (v[0] + v[1]) + (v[2] + v[3]);
                    float sq = (j < 3) ? s : 0.f, sk = (j >= 3 && j < 5) ? s : 0.f;
                    sq += __shfl_xor(sq, 1); sq += __shfl_xor(sq, 2); sq += __shfl_xor(sq, 4);
                    sk += __shfl_xor(sk, 1); sk += __shfl_xor(sk, 2); sk += __shfl_xor(sk, 4);
                    if (j == 0) { rstd[T_TOK + row] = __builtin_amdgcn_rsqf(sq * (1.0f / 384.0f) + EPSN); rstd[2 * T_TOK + row] = __builtin_amdgcn_rsqf(sk * (1.0f / 256.0f) + EPSN); }
                }
                xcd_barrier(xb);
            }
#pragma unroll 1
            for (int gi0 = 0; gi0 < ng * ((slot == 4) ? REP_M1 : 1); ++gi0) {
                const int gi = (slot == 4) ? 0 : gi0;
                const GDesc d = get_gemm(p, layer, slot, gi);
                pg8::StaticOrder S; S.init(d.g.M, d.g.N, G, bid);
                pg8::gemm_phase(lds, d.g, S, d.E);
            }
            unsigned char* ws = p.ws;
            const int tid = opaque_tid();
            if (slot == 1 && even) {
                const bf16_t* proj = (const bf16_t*)(ws + WS_R + R_PROJ);
                bf16_t* att = (bf16_t*)(ws + WS_R + R_ATT);
                bf16_t* obuf = (bf16_t*)(ws + WS_OBUF);
                float* lseb = (float*)(ws + WS_LSE);
                const float* biasT = (const float*)(ws + WS_BIAS);
#pragma unroll 1
                for (int u0 = bid; u0 < 2560 * REP_E2; u0 += G) {
                    const int u = u0 % 2560;
                    int qc, kc, vc, ldo, ld_lse, W, tok0, dl, q0, has_sink, bh; bf16_t* op; float* lp; float sink2 = 0.f;
                    if (u < 1024) {
                        const int b = u >> 9, hq = (u >> 6) & 7, qblk = u & 63, kvh = hq >> 2;
                        qc = hq * 64; kc = 512 + kvh * 64; vc = 640 + kvh * 64; op = att + hq * 64; ldo = 768; lp = nullptr; ld_lse = 0; bh = hq;
                        sink2 = p.in[6][li * 8 + hq] * LOG2E; has_sink = 1; W = 127; tok0 = b * SEQ; dl = 1; q0 = qblk * 256;
                    } else {
                        const int v = u - 1024, g = v >> 9, w = v & 511, b = w >> 8, hbh = (w >> 6) & 3, j = w & 63;
                        dl = (g == 0) ? 1 : (g == 1 ? 4 : 16); const int nqb = 64 / dl, r = j / nqb, qblk = j % nqb;
                        qc = 768 + ((g * 3 + 0) * 4 + hbh) * 64; kc = 768 + ((g * 3 + 1) * 4 + hbh) * 64; vc = 768 + ((g * 3 + 2) * 4 + hbh) * 64;
                        op = obuf + (size_t)g * T_TOK * 256 + hbh * 64; ldo = 256; lp = lseb + (size_t)g * T_TOK * 4 + hbh; ld_lse = 4; bh = 8 + g * 4 + hbh;
                        has_sink = 0; W = 128; tok0 = b * SEQ + r; q0 = qblk * 256;
                    }
                    attn_unit<1>(lds, proj + qc, 3072, proj + kc, 3072, nullptr, proj + vc, 3072, op, ldo, lp, ld_lse,
                                 nullptr, biasT + bh * 512, sink2, has_sink, W, tok0, dl, q0, 0.18033688011112042f);
                }
            } else if (slot == 2 && even) {
                bf16_t* att = (bf16_t*)(ws + WS_R + R_ATT);
                const bf16_t* obuf = (const bf16_t*)(ws + WS_OBUF);
                const float* lseb = (const float*)(ws + WS_LSE);
                for (int idx = bid * 512 + tid; idx < T_TOK * 32; idx += G * 512) {
                    const int tok = idx >> 5, hbh = (idx >> 3) & 3, c = idx & 7;
                    const float l0 = lseb[(size_t)tok * 4 + hbh], l1 = lseb[(size_t)(T_TOK + tok) * 4 + hbh], l2 = lseb[(size_t)(2 * T_TOK + tok) * 4 + hbh];
                    const float mx = fmaxf(l0, fmaxf(l1, l2));
                    float w0 = __expf(l0 - mx), w1 = __expf(l1 - mx), w2 = __expf(l2 - mx);
                    const float inv = 1.0f / (w0 + w1 + w2); w0 *= inv; w1 *= inv; w2 *= inv;
                    const size_t oo = (size_t)tok * 256 + hbh * 64 + c * 8;
                    const u32x4 a = *(const u32x4*)(obuf + oo), b = *(const u32x4*)(obuf + (size_t)T_TOK * 256 + oo), d = *(const u32x4*)(obuf + (size_t)2 * T_TOK * 256 + oo);
                    u32x4 r;
#pragma unroll
                    for (int k = 0; k < 4; ++k)
                        r[k] = cvt_pk_bf16(w0 * bflo(a[k]) + w1 * bflo(b[k]) + w2 * bflo(d[k]), w0 * bfhi(a[k]) + w1 * bfhi(b[k]) + w2 * bfhi(d[k]));
                    *(u32x4*)(att + (size_t)tok * 768 + 512 + hbh * 64 + c * 8) = r;
                }
            } else if (slot == 1 && !even) {
                const bf16_t* down = (const bf16_t*)(ws + WS_R + R_DOWN);
                bf16_t* krope = (bf16_t*)(ws + WS_R + R_KROPE);
                const float* rope_cs = (const float*)(ws + WS_ROPE);
                for (int idx = bid * 512 + tid; idx < T_TOK * 16; idx += G * 512) {
                    const int tok = idx >> 4, i = idx & 15, pos = tok & (SEQ - 1);
                    const float t1 = bf2f(down[(size_t)tok * 768 + 640 + i]), t2 = bf2f(down[(size_t)tok * 768 + 656 + i]);
                    const f32x2 cs = *(const f32x2*)(rope_cs + ((size_t)pos * 16 + i) * 2);
                    krope[(size_t)tok * 32 + i] = (bf16_t)(cvt_pk_bf16(t1 * cs[0] - t2 * cs[1], 0.f) & 0xffffu);
                    krope[(size_t)tok * 32 + 16 + i] = (bf16_t)(cvt_pk_bf16(t1 * cs[1] + t2 * cs[0], 0.f) & 0xffffu);
                }
            } else if (slot == 2 && !even) {
                const bf16_t* qbuf = (const bf16_t*)(ws + WS_R + R_Q);
                const bf16_t* kvb = (const bf16_t*)(ws + WS_R + R_KV);
                const bf16_t* krope = (const bf16_t*)(ws + WS_R + R_KROPE);
                bf16_t* att = (bf16_t*)(ws + WS_R + R_ATT);
                const float* rope_cs = (const float*)(ws + WS_ROPE);
                const int vbid = (G == 256) ? ((bid & 7) * 32 + (bid >> 3)) : bid;
#pragma unroll 1
                for (int it0 = vbid; it0 < 1024 * REP_O3; it0 += G) {
                    const int it = it0 % 1024;
                    const int half = it / 512, pr = it % 512;
                    const int bh = pr >> 5, x = pr & 31, b = bh >> 3, hh = bh & 7;
                    const int qblk = half == 0 ? 63 - x : x;
                    attn_unit<0>(lds, qbuf + hh * 96, 768, kvb + hh * 128, 1024, krope, kvb + hh * 128 + 64, 1024, att + hh * 64, 512, nullptr, 0,
                                 rope_cs, nullptr, 0.f, 0, 0, b * SEQ, 1, qblk * 256, 0.14724444602590306f);
                }
            }
            for (int rs_ = 0; rs_ < REP_SYNC; ++rs_) xcd_barrier(xb);
        }
    }
    {
        const float* fn = p.in[4]; float* outp = p.out; const float* partH = (const float*)(p.ws + WS_PARTH); const bf16_t* hb = (const bf16_t*)(p.ws + WS_HB);
        const int tid = opaque_tid(), wid = tid >> 6, lane = tid & 63;
        for (int row = bid * 8 + wid; row < T_TOK; row += G * 8) {
            const f32x4 pa = *(const f32x4*)(partH + (size_t)row * 4);
            const float ss = (pa[0] + pa[1]) + (pa[2] + pa[3]);
            const float rs = __builtin_amdgcn_rsqf(ss * (1.0f / 1024.0f) + EPSN);
#pragma unroll
            for (int i = 0; i < 2; ++i) {
                const size_t o = (size_t)row * DM + i * 512 + lane * 8;
                const u32x4 r = *(const u32x4*)(hb + o);
                const f32x4 g0 = *(const f32x4*)(fn + i * 512 + lane * 8), g1 = *(const f32x4*)(fn + i * 512 + lane * 8 + 4);
                f32x4 v0, v1;
                v0[0] = bflo(r.x) * rs * g0[0]; v0[1] = bfhi(r.x) * rs * g0[1]; v0[2] = bflo(r.y) * rs * g0[2]; v0[3] = bfhi(r.y) * rs * g0[3];
                v1[0] = bflo(r.z) * rs * g1[0]; v1[1] = bfhi(r.z) * rs * g1[1]; v1[2] = bflo(r.w) * rs * g1[2]; v1[3] = bfhi(r.w) * rs * g1[3];
                *(f32x4*)(outp + o) = v0; *(f32x4*)(outp + o + 4) = v1;
            }
        }
    }
}

extern "C" void kernel_launch(void* const* d_in, const int* in_sizes, int n_in, void* d_out, int out_size, void* d_ws, size_t ws_size, hipStream_t stream) {
    static int grid_blocks = 0;
    if (grid_blocks == 0) {
        if (n_in != 16 || out_size != T_TOK * DM || ws_size < WS_END) { fprintf(stderr, "kernel_launch: unexpected shapes (n_in %d out %d ws %zu)\n", n_in, out_size, ws_size); grid_blocks = -1; return; }
        int dev = 0, cus = 0, per_cu = 0;
        hipGetDevice(&dev);
        hipDeviceGetAttribute(&cus, hipDeviceAttributeMultiprocessorCount, dev);
        if (hipFuncSetAttribute((const void*)trunk_fwd, hipFuncAttributeMaxDynamicSharedMemorySize, LDS_BYTES) != hipSuccess) { fprintf(stderr, "kernel_launch: hipFuncSetAttribute failed\n"); grid_blocks = -1; return; }
        if (hipOccupancyMaxActiveBlocksPerMultiprocessor(&per_cu, (const void*)trunk_fwd, 512, LDS_BYTES) != hipSuccess || per_cu < 1) { fprintf(stderr, "kernel_launch: occupancy query gave %d\n", per_cu); per_cu = 1; }
        (void)hipGetLastError();
        grid_blocks = cus * 1;
    }
    if (grid_blocks < 0) return;
    if (hipMemsetAsync((char*)d_ws + WS_BAR, 0, XCD_BAR_WORDS * sizeof(unsigned), stream) != hipSuccess) { fprintf(stderr, "kernel_launch: memset of barrier words failed\n"); return; }
    Params p{};
    for (int i = 0; i < 16; ++i) p.in[i] = (const float*)d_in[i];
    p.out = (float*)d_out; p.ws = (unsigned char*)d_ws;
    void* args[] = {&p};
    hipError_t e = hipLaunchCooperativeKernel((const void*)trunk_fwd, dim3(grid_blocks), dim3(512), args, LDS_BYTES, stream);
    if (e != hipSuccess) fprintf(stderr, "cooperative launch failed: %s (grid %d)\n", hipGetErrorString(e), grid_blocks);
}
```

```cpp
#include <hip/hip_runtime.h>
#include <hip/hip_cooperative_groups.h>
#include <cstdio>
#include <cstdint>
namespace cg = cooperative_groups;

#define LAS __attribute__((address_space(3)))
#define DI __device__ __forceinline__
typedef unsigned short bf16_t;
typedef short bf16x8 __attribute__((ext_vector_type(8)));
typedef short s16x4 __attribute__((ext_vector_type(4)));
typedef float f32x4 __attribute__((ext_vector_type(4)));
typedef float f32x2 __attribute__((ext_vector_type(2)));
typedef float f32x16 __attribute__((ext_vector_type(16)));
typedef unsigned u32x4 __attribute__((ext_vector_type(4)));
typedef unsigned u32x2 __attribute__((ext_vector_type(2)));

constexpr int T_TOK = 32768, SEQ = 16384, DM = 1024, DFF = 4096;
constexpr float LOG2E = 1.4426950408889634f, LN2 = 0.6931471805599453f, EPSN = 1e-6f;
constexpr size_t MiB = 1u << 20;
constexpr size_t WS_HB = 0, WS_R = 64 * MiB, WS_OBUF = 320 * MiB, WS_W = 368 * MiB, WS_PARTH = 456 * MiB, WS_PARTO = 458 * MiB,
                 WS_ROPE = 462 * MiB, WS_LSE = 464 * MiB, WS_BIAS = 466 * MiB, WS_BAR = 467 * MiB, WS_RSTD = 468 * MiB, WS_END = 469 * MiB;
constexpr size_t R_PROJ = 0, R_ATT = 192 * MiB, R_DOWN = 0, R_Q = 48 * MiB, R_KV = 96 * MiB, R_KROPE = 160 * MiB, R_HID = 0;
constexpr size_t W_IN = 0, W_OUT = 6291456, W_DC = 7864320, W_UQ = 9437184, W_UKV = 10027008, W_O = 10551296, W_UP = 11599872, W_DN = 28377088;
constexpr int LDS_MAIN = 131072, LDS_RS = LDS_MAIN + 16, LDS_BYTES = LDS_RS + 16384;

#ifndef REP_SYNC
#define REP_SYNC 1
#endif
#ifndef REP_P0
#define REP_P0 1
#endif
#ifndef REP_O3
#define REP_O3 1
#endif
#ifndef REP_E2
#define REP_E2 1
#endif
#ifndef REP_M1
#define REP_M1 1
#endif
struct Params { const float* in[16]; float* out; unsigned char* ws; };

typedef __bf16 bf16x2_t __attribute__((ext_vector_type(2)));
typedef __bf16 bf16x8_t __attribute__((ext_vector_type(8)));
DI unsigned cvt_pk_bf16_mm(float lo, float hi) { const f32x2 v = {lo, hi}; return __builtin_bit_cast(unsigned, __builtin_convertvector(v, bf16x2_t)); }
DI unsigned cvt_pk_bf16(float lo, float hi) { unsigned r; asm("v_cvt_pk_bf16_f32 %0, %1, %2" : "=v"(r) : "v"(lo), "v"(hi)); return r; }
DI int opaque_tid() { int t = threadIdx.x; asm volatile("" : "+v"(t)); return t; }
DI float bf2f(bf16_t v) { return __uint_as_float(((unsigned)v) << 16); }
DI float bflo(unsigned u) { return __uint_as_float(u << 16); }
DI float bfhi(unsigned u) { return __uint_as_float(u & 0xffff0000u); }


#define XB_TMO      128
#define XB_XCNT(j)  (256  + 64 * (j))
#define XB_XSUB(j)  (1280 + 64 * (j))
#define XB_XGEN(j)  (2304 + 64 * (j))
#define XB_TOP      3328
#define XB_TOPGEN   3392
#define XCD_BAR_WORDS 3456
#define XB_SPIN_CAP (1u << 18)
DI unsigned xb_ld(unsigned* p)              { return __hip_atomic_load(p, __ATOMIC_RELAXED, __HIP_MEMORY_SCOPE_AGENT); }
DI unsigned xb_add(unsigned* p, unsigned v) { return __hip_atomic_fetch_add(p, v, __ATOMIC_RELAXED, __HIP_MEMORY_SCOPE_AGENT); }
DI unsigned xb_xcc_id() { return (unsigned)__builtin_amdgcn_s_getreg((3 << 11) | 20) & 0xFu; }
#define XB_SPIN(cond, bar) do { unsigned _sp = 0; while (cond) { __builtin_amdgcn_s_sleep(1); \
    if ((++_sp & 255u) == 0u) { if (xb_ld(&(bar)[XB_TMO])) break; if (_sp > XB_SPIN_CAP) { atomicAdd(&(bar)[XB_TMO], 1u); break; } } } } while (0)
struct XcdBarrier { unsigned* bar; unsigned x; volatile LAS unsigned* st; };
DI XcdBarrier xcd_barrier_post(unsigned* bar, volatile LAS unsigned* st) {
    XcdBarrier b; b.bar = bar; b.x = xb_xcc_id(); b.st = st;
    if (threadIdx.x == 0) (void)xb_add(&bar[XB_XCNT(b.x)], 1u);
    return b;
}
DI void xcd_barrier_complete(unsigned* bar, unsigned x, unsigned& nloc, unsigned& nx) {
    const unsigned G = gridDim.x * gridDim.y * gridDim.z;
    unsigned sum, cnt, mine, sp = 0u;
    for (;;) {
        sum = 0u; cnt = 0u; mine = 0u;
#pragma unroll
        for (unsigned j = 0; j < 16; ++j) { const unsigned c = xb_ld(&bar[XB_XCNT(j)]); sum += c; cnt += (c > 0u) ? 1u : 0u; mine = (j == x) ? c : mine; }
        if (sum == G) break;
        __builtin_amdgcn_s_sleep(1);
        if ((++sp & 255u) == 0u) { if (xb_ld(&bar[XB_TMO])) break; if (sp > XB_SPIN_CAP) { atomicAdd(&bar[XB_TMO], 1u); break; } }
    }
    nloc = mine > 0u ? mine : 1u; nx = cnt > 0u ? cnt : 1u;
}
DI void xcd_barrier(const XcdBarrier& b) {
    asm volatile("s_waitcnt vmcnt(0)" ::: "memory");
    __syncthreads();
    if (threadIdx.x == 0) {
        unsigned* bar = b.bar;
        __builtin_amdgcn_s_waitcnt(0);
        unsigned nloc = b.st[0], nx = b.st[1];
        if (nloc == 0u) { xcd_barrier_complete(bar, b.x, nloc, nx); b.st[0] = nloc; b.st[1] = nx; }
        const unsigned old = xb_add(&bar[XB_XSUB(b.x)], 1u);
        const unsigned gen = old / nloc;
        if (old + 1u == (gen + 1u) * nloc) {
            __builtin_amdgcn_fence(__ATOMIC_RELEASE, "agent");
            asm volatile("s_waitcnt vmcnt(0)" ::: "memory");
            const unsigned og = xb_add(&bar[XB_TOP], 1u);
            const unsigned tg = og / nx;
            if (og + 1u == (tg + 1u) * nx) xb_add(&bar[XB_TOPGEN], 1u);
            else XB_SPIN(xb_ld(&bar[XB_TOPGEN]) == tg, bar);
            __builtin_amdgcn_fence(__ATOMIC_ACQUIRE, "agent");
            xb_add(&bar[XB_XGEN(b.x)], 1u);
            asm volatile("s_waitcnt vmcnt(0)" ::: "memory");
        } else {
            XB_SPIN(xb_ld(&bar[XB_XGEN(b.x)]) == gen, bar);
            __builtin_amdgcn_fence(__ATOMIC_ACQUIRE, "agent");
            asm volatile("s_waitcnt vmcnt(0)" ::: "memory");
        }
    }
    __syncthreads();
}

namespace pg8 {
constexpr int BM = 256, BK = 64, HALF = 128, HTB = HALF * BK * 2, NXCD = 8, WGM = 8;
DI int lds_byte(int r, int c) { const int st = (r >> 4) * 2 + (c >> 5), rr = r & 15, cc = c & 31, ob = rr * 64 + cc * 2; return st * 1024 + (ob ^ (((ob >> 9) & 1) << 5)); }
DI void stage_rc(int b, int& R, int& C) { const int st = b / 1024, sb = b % 1024, swz = sb ^ (((sb >> 9) & 1) << 5); R = (st >> 1) * 16 + swz / 64; C = (st & 1) * 32 + (swz % 64) / 2; }
DI int perm32(int rho) { const int n = rho >> 4, i = rho & 15; return 8 * (i >> 2) + 4 * n + (i & 3); }
struct Unit { int pm, pn; };
struct Gemm { const bf16_t* A; int lda; const bf16_t* Bt; int M, N, K; };
struct StaticOrder {
    int nM, nN, nwg, G, c;
    DI void init(int M, int N, int G_, int c_) { nM = M / BM; nN = N / BM; nwg = nM * nN; G = G_; c = c_; }
    DI bool next(int i, Unit& u) const {
        const long L = (long)i * G + c; if (L >= nwg) return false;
        int wgid = (int)L; { const int q = nwg / NXCD, r = nwg % NXCD, xcd = wgid % NXCD, off = wgid / NXCD; wgid = (xcd < r ? xcd * (q + 1) : r * (q + 1) + (xcd - r) * q) + off; }
        const int nig = WGM * nN, gid = wgid / nig, fm = gid * WGM, gsz = (nM - fm) < WGM ? (nM - fm) : WGM;
        u.pm = fm + ((wgid % nig) % gsz); u.pn = (wgid % nig) / gsz; return true;
    }
};

struct Epi {
    int mode;
    bf16_t* O; int ldo; const float* rstd; int rs4; int relu2; float* part_out;
    template <int RELU2, int PART>
    DI void scale_store(const f32x4 (&acc)[2][2][4][2], const Unit& u, int wr, int wc, int fr, int fq, LAS const float* rsl) const {
            float rsv[2][4];
#pragma unroll
            for (int ai = 0; ai < 2; ++ai)
#pragma unroll
                for (int m = 0; m < 4; ++m) {
                    if (rs4) { const f32x4 v = ((LAS const f32x4*)rsl)[ai * 64 + m * 16 + fr]; rsv[ai][m] = __builtin_amdgcn_rsqf(((v[0] + v[1]) + (v[2] + v[3])) * (1.0f / 1024.0f) + EPSN); }
                    else rsv[ai][m] = rsl[ai * 64 + m * 16 + fr];
                }
#pragma unroll
            for (int ai = 0; ai < 2; ++ai)
#pragma unroll
                for (int m = 0; m < 4; ++m) {
                    const int row = u.pm * BM + ai * HALF + wr * 64 + m * 16 + fr;
                    const float rs = rsv[ai][m];
#pragma unroll
                    for (int bj = 0; bj < 2; ++bj) {
                        const int col = u.pn * BM + bj * HALF + wc * 32 + 8 * fq;
                        f32x4 v0 = acc[ai][bj][m][0] * rs, v1 = acc[ai][bj][m][1] * rs;
                        if (RELU2) {
#pragma unroll
                            for (int e = 0; e < 4; ++e) { const float a = fmaxf(v0[e], 0.f), b = fmaxf(v1[e], 0.f); v0[e] = a * a; v1[e] = b * b; }
                        }
                        u32x4 w; w.x = cvt_pk_bf16(v0[0], v0[1]); w.y = cvt_pk_bf16(v0[2], v0[3]); w.z = cvt_pk_bf16(v1[0], v1[1]); w.w = cvt_pk_bf16(v1[2], v1[3]);
                        *(u32x4*)(O + (size_t)row * ldo + col) = w;
                        if (PART) {
                            float sq = (v0[0] * v0[0] + v0[1] * v0[1]) + (v0[2] * v0[2] + v0[3] * v0[3]) + (v1[0] * v1[0] + v1[1] * v1[1]) + (v1[2] * v1[2] + v1[3] * v1[3]);
                            sq += __shfl_xor(sq, 16); sq += __shfl_xor(sq, 32);
                            if (fq == 0) part_out[(size_t)row * 32 + u.pn * 8 + bj * 4 + wc] = sq;
                        }
                    }
                }
    }
    DI void operator()(const f32x4 (&acc)[2][2][4][2], const Unit& u, int wr, int wc, int fr, int fq, LAS const float* rsl, LAS float* red) const {
        if (mode == 0) {
            if (relu2) scale_store<1, 0>(acc, u, wr, wc, fr, fq, rsl);
            else if (part_out) scale_store<0, 1>(acc, u, wr, wc, fr, fq, rsl);
            else scale_store<0, 0>(acc, u, wr, wc, fr, fq, rsl);
        } else {
#pragma unroll
            for (int ai = 0; ai < 2; ++ai) {
                u32x4 rr[4][2];
#pragma unroll
                for (int m = 0; m < 4; ++m)
#pragma unroll
                    for (int bj = 0; bj < 2; ++bj)
                        rr[m][bj] = *(const u32x4*)(O + (size_t)(u.pm * BM + ai * HALF + wr * 64 + m * 16 + fr) * DM + u.pn * BM + bj * HALF + wc * 32 + 8 * fq);
#pragma unroll
                for (int m = 0; m < 4; ++m) {
                    const int row = u.pm * BM + ai * HALF + wr * 64 + m * 16 + fr; float ss = 0.f;
#pragma unroll
                    for (int bj = 0; bj < 2; ++bj) {
                        const int col = u.pn * BM + bj * HALF + wc * 32 + 8 * fq;
                        const size_t o = (size_t)row * DM + col;
                        const u32x4 r = rr[m][bj];
                        f32x4 v0 = acc[ai][bj][m][0], v1 = acc[ai][bj][m][1];
                        v0[0] += bflo(r.x); v0[1] += bfhi(r.x); v0[2] += bflo(r.y); v0[3] += bfhi(r.y); v1[0] += bflo(r.z); v1[1] += bfhi(r.z); v1[2] += bflo(r.w); v1[3] += bfhi(r.w);
                        u32x4 w; w.x = cvt_pk_bf16(v0[0], v0[1]); w.y = cvt_pk_bf16(v0[2], v0[3]); w.z = cvt_pk_bf16(v1[0], v1[1]); w.w = cvt_pk_bf16(v1[2], v1[3]);
                        *(u32x4*)(O + o) = w;
                        ss += (v0[0] * v0[0] + v0[1] * v0[1]) + (v0[2] * v0[2] + v0[3] * v0[3]) + (v1[0] * v1[0] + v1[1] * v1[1]) + (v1[2] * v1[2] + v1[3] * v1[3]);
                    }
                    ss += __shfl_xor(ss, 16); ss += __shfl_xor(ss, 32);
                    if (fq == 0) red[(((wr * 4 + wc) * 8) + ai * 4 + m) * 16 + fr] = ss;
                }
            }
            asm volatile("s_waitcnt lgkmcnt(0)" ::: "memory"); __builtin_amdgcn_s_barrier(); asm volatile("" ::: "memory");
            const int lane = fq * 16 + fr;
            if (lane < 32) {
                const int q = 2 * wc + (lane >> 4), f2 = lane & 15;
                float t = 0.f;
#pragma unroll
                for (int w2 = 0; w2 < 4; ++w2) t += red[(((wr * 4 + w2) * 8) + q) * 16 + f2];
                const int row = u.pm * BM + (q >> 2) * HALF + wr * 64 + (q & 3) * 16 + f2;
                part_out[(size_t)row * 4 + u.pn] = t;
            }
        }
    }
};

DI void gemm_phase(LAS unsigned char* lds, const Gemm g, const StaticOrder& S, const Epi& E) {
    const int tid = opaque_tid(), wid = __builtin_amdgcn_readfirstlane(tid >> 6), lane = tid & 63, wr = wid >> 2, wc = wid & 3, fr = lane & 15, fq = lane >> 4;
    const int K = g.K, nt = K / BK, lda = g.lda;
    unsigned voffA[2], voffB[2];
#pragma unroll
    for (int i = 0; i < 2; ++i) { int R, C; stage_rc(tid * 16 + i * 8192, R, C); const int Rb = (R & ~31) + perm32(R & 31);
        voffA[i] = (unsigned)(R * lda + C) * 2u; voffB[i] = (unsigned)(Rb * K + C) * 2u; }
    const size_t kstep = (size_t)(BK * 2);
    const size_t hstepA = (size_t)HALF * lda * 2, hstepB = (size_t)HALF * K * 2;
    const size_t tstepA = 2 * hstepA, tstepB = 2 * hstepB;
    const unsigned ldsw = (unsigned)wid * 1024u;
    const int aoff = lds_byte(wr * 64 + fr, fq * 8), boff = lds_byte(wc * 32 + fr, fq * 8);
#define PG8_SA(b, h) (((b) * 2 + (h)) * HTB)
#define PG8_SB(b, h) ((4 + (b) * 2 + (h)) * HTB)
#define PG8_STAGE(bufoff, gbase, voff) do { _Pragma("unroll") for (int _i = 0; _i < 2; ++_i) \
        __builtin_amdgcn_global_load_lds((const unsigned*)((const char*)(gbase) + (voff)[_i]), (LAS unsigned*)(lds + (bufoff) + ldsw + _i * 8192), 16, 0, 0); } while (0)
#define PG8_LDA(dst, b, h) do { _Pragma("unroll") for (int m = 0; m < 4; ++m) _Pragma("unroll") for (int k = 0; k < 2; ++k) dst[m][k] = *(const LAS bf16x8*)(lds + PG8_SA(b, h) + aoff + m * 2048 + k * 1024); } while (0)
#define PG8_LDB(dst, b, h) do { _Pragma("unroll") for (int n = 0; n < 2; ++n) _Pragma("unroll") for (int k = 0; k < 2; ++k) dst[n][k] = *(const LAS bf16x8*)(lds + PG8_SB(b, h) + boff + n * 2048 + k * 1024); } while (0)
#define PG8_MMA(ai, bj, At, Bt) do { __builtin_amdgcn_s_setprio(1); _Pragma("unroll") for (int m = 0; m < 4; ++m) _Pragma("unroll") for (int n = 0; n < 2; ++n) _Pragma("unroll") for (int k = 0; k < 2; ++k) \
        acc[ai][bj][m][n] = __builtin_amdgcn_mfma_f32_16x16x32_bf16(Bt[n][k], At[m][k], acc[ai][bj][m][n], 0, 0, 0); __builtin_amdgcn_s_setprio(0); } while (0)
#define PG8_WAIT_V(n) asm volatile("s_waitcnt vmcnt(" #n ")" ::: "memory")
#define PG8_WAIT_L(n) asm volatile("s_waitcnt lgkmcnt(" #n ")" ::: "memory")
#define PG8_BAR __builtin_amdgcn_s_barrier()
#define PG8_SCHED __builtin_amdgcn_sched_barrier(0)
    Unit cur, nxt; int ui = 0;
    if (!S.next(0, cur)) return;
    f32x4 acc[2][2][4][2];
#pragma unroll
    for (int a = 0; a < 2; ++a)
#pragma unroll
        for (int b = 0; b < 2; ++b)
#pragma unroll
            for (int m = 0; m < 4; ++m)
#pragma unroll
                for (int n = 0; n < 2; ++n) acc[a][b][m][n] = (f32x4){0.f, 0.f, 0.f, 0.f};
    bf16x8 At[4][2], B0[2][2], B1[2][2];
    const char* cA = (const char*)g.A + (size_t)cur.pm * tstepA; const char* cB = (const char*)g.Bt + (size_t)cur.pn * tstepB;
    LAS float* rsl = (LAS float*)(lds + LDS_RS) + wid * 512;
#define PG8_RS_DMA(u_) do { if (E.mode == 0) { if (E.rs4) { _Pragma("unroll") for (int ai_ = 0; ai_ < 2; ++ai_) \
            __builtin_amdgcn_global_load_lds((const unsigned*)(E.rstd + (size_t)((u_).pm * BM + ai_ * HALF + wr * 64 + lane) * 4), (LAS unsigned*)(rsl + ai_ * 256), 16, 0, 0); } \
        else { _Pragma("unroll") for (int ai_ = 0; ai_ < 2; ++ai_) \
            __builtin_amdgcn_global_load_lds((const unsigned*)(E.rstd + (u_).pm * BM + ai_ * HALF + wr * 64 + lane), (LAS unsigned*)(rsl + ai_ * 64), 4, 0, 0); } } } while (0)
    PG8_RS_DMA(cur);
    PG8_STAGE(PG8_SB(0, 0), cB, voffB); PG8_STAGE(PG8_SB(0, 1), cB + hstepB, voffB); PG8_STAGE(PG8_SA(0, 0), cA, voffA); PG8_STAGE(PG8_SA(0, 1), cA + hstepA, voffA);
    if (wr == 1) PG8_BAR;
    PG8_WAIT_V(2); PG8_BAR;
    PG8_STAGE(PG8_SB(1, 0), cB + kstep, voffB); PG8_STAGE(PG8_SA(1, 0), cA + kstep, voffA); PG8_STAGE(PG8_SB(1, 1), cB + hstepB + kstep, voffB);
    PG8_WAIT_V(6); PG8_BAR;
    for (;;) {
        const bool has_next = S.next(ui + 1, nxt);
        const char* nA = has_next ? (const char*)g.A + (size_t)nxt.pm * tstepA : cA; const char* nB = has_next ? (const char*)g.Bt + (size_t)nxt.pn * tstepB : cB;
        for (int t = 0; t < nt; t += 2) {
            const bool last = (t == nt - 2);
            const char* a1 = cA + (size_t)(t + 1) * kstep;
            const char* a2 = last ? nA : cA + (size_t)(t + 2) * kstep; const char* b2 = last ? nB : cB + (size_t)(t + 2) * kstep;
            const char* a3 = a2 + kstep; const char* b3 = b2 + kstep;
            PG8_LDB(B0, 0, 0); PG8_LDB(B1, 0, 1); PG8_SCHED; PG8_LDA(At, 0, 0); PG8_STAGE(PG8_SA(1, 1), a1 + hstepA, voffA);
            PG8_WAIT_V(8); PG8_WAIT_L(0); PG8_BAR; PG8_MMA(0, 0, At, B0); PG8_MMA(0, 1, At, B1); PG8_BAR; PG8_SCHED;
            PG8_LDA(At, 0, 1); PG8_STAGE(PG8_SB(0, 0), b2, voffB); PG8_STAGE(PG8_SB(0, 1), b2 + hstepB, voffB); PG8_STAGE(PG8_SA(0, 0), a2, voffA);
            PG8_WAIT_V(8); PG8_WAIT_L(0); PG8_BAR; PG8_MMA(1, 0, At, B0); PG8_MMA(1, 1, At, B1); PG8_BAR; PG8_SCHED;
            PG8_LDB(B0, 1, 0); PG8_LDB(B1, 1, 1); PG8_SCHED; PG8_LDA(At, 1, 0); PG8_STAGE(PG8_SA(0, 1), a2 + hstepA, voffA);
            PG8_WAIT_V(8); PG8_WAIT_L(0); PG8_BAR; PG8_MMA(0, 0, At, B0); PG8_MMA(0, 1, At, B1); PG8_BAR; PG8_SCHED;
            PG8_LDA(At, 1, 1); PG8_STAGE(PG8_SB(1, 0), b3, voffB); PG8_STAGE(PG8_SB(1, 1), b3 + hstepB, voffB); PG8_STAGE(PG8_SA(1, 0), a3, voffA);
            PG8_WAIT_V(8); PG8_WAIT_L(0); PG8_BAR; PG8_MMA(1, 0, At, B0); PG8_MMA(1, 1, At, B1); PG8_BAR; PG8_SCHED;
        }
        if (wr == 0) PG8_BAR;
        E(acc, cur, wr, wc, fr, fq, rsl, (LAS float*)(lds + LDS_RS));
        if (!has_next) break;
        PG8_RS_DMA(nxt);
#pragma unroll
        for (int a = 0; a < 2; ++a)
#pragma unroll
            for (int b = 0; b < 2; ++b)
#pragma unroll
                for (int m = 0; m < 4; ++m)
#pragma unroll
                    for (int n = 0; n < 2; ++n) acc[a][b][m][n] = (f32x4){0.f, 0.f, 0.f, 0.f};
        cur = nxt; cA = nA; cB = nB; ++ui;
        if (wr == 1) PG8_BAR;
    }
    PG8_WAIT_V(0);
    PG8_BAR;
#undef PG8_RS_DMA
#undef PG8_SA
#undef PG8_SB
#undef PG8_STAGE
#undef PG8_LDA
#undef PG8_LDB
#undef PG8_MMA
#undef PG8_WAIT_V
#undef PG8_WAIT_L
#undef PG8_BAR
#undef PG8_SCHED
}

}

constexpr int AK_STRIDE = 208, AV_STRIDE = 144, AV_OFF = 64 * AK_STRIDE, A_STAGE = AV_OFF + 64 * AV_STRIDE, A_TAB = 4 * A_STAGE;
DI float max3f(float a, float b, float c) { float r; asm("v_max3_f32 %0, %1, %2, %3" : "=v"(r) : "v"(a), "v"(b), "v"(c)); return r; }
DI int crow(int i, int h) { return (i & 3) + 8 * (i >> 2) + 4 * h; }
#define MFMA32(a, b, c) __builtin_amdgcn_mfma_f32_32x32x16_bf16((a), (b), (c), 0, 0, 0)
typedef short v4i16_t __attribute__((ext_vector_type(4)));
DI s16x4 vtr(LAS const unsigned char* p) { return __builtin_bit_cast(s16x4, __builtin_amdgcn_ds_read_tr16_b64_v4i16((LAS v4i16_t*)p)); }

template <int MODE>
DI void attn_unit(LAS unsigned char* lds, const bf16_t* __restrict__ Qp, int ldq, const bf16_t* __restrict__ Kp, int ldk, const bf16_t* __restrict__ KRp,
                  const bf16_t* __restrict__ Vp, int ldv, bf16_t* __restrict__ Op, int ldo, float* __restrict__ lse_out, int ld_lse,
                  const float* __restrict__ rope_cs, const float* __restrict__ bias_g, float sink2, int has_sink, int W,
                  int tok0, int dil, int q0, float cscale) {
    constexpr int NKS = MODE == 0 ? 6 : 4;
    const int tid = opaque_tid(), wid = __builtin_amdgcn_readfirstlane(tid >> 6), lane = tid & 63, ql = lane & 31, h = lane >> 5;
    __builtin_assume(wid >= 0 && wid < 8);
    const int qa = q0 + 32 * wid, qb = qa + 31, qsub = qa + ql;
    const long qtok = (long)tok0 + (long)qsub * dil;
    bf16x8 qf[NKS];
    {
        const bf16_t* qptr = Qp + qtok * ldq;
#pragma unroll
        for (int s = 0; s < 4; ++s) qf[s] = *(const bf16x8*)(qptr + 16 * s + 8 * h);
        if constexpr (MODE == 0) {
            const u32x4 t1 = *(const u32x4*)(qptr + 64 + 8 * h), t2 = *(const u32x4*)(qptr + 80 + 8 * h);
            const float* cs = rope_cs + ((size_t)qsub * 16 + 8 * h) * 2;
            u32x4 o1, o2;
#pragma unroll
            for (int jj = 0; jj < 4; ++jj) {
                const f32x4 c4 = *(const f32x4*)(cs + 4 * jj);
                const float a0 = bflo(t1[jj]), a1 = bfhi(t1[jj]), b0 = bflo(t2[jj]), b1 = bfhi(t2[jj]);
                o1[jj] = cvt_pk_bf16_mm(a0 * c4[0] - b0 * c4[1], a1 * c4[2] - b1 * c4[3]);
                o2[jj] = cvt_pk_bf16_mm(a0 * c4[1] + b0 * c4[0], a1 * c4[3] + b1 * c4[2]);
            }
            qf[4] = __builtin_bit_cast(bf16x8, o1); qf[5] = __builtin_bit_cast(bf16x8, o2);
        }
    }
    int kt_lo = 0; const int kt_hi = (q0 >> 6) + 3;
    if constexpr (MODE == 1) { kt_lo = (q0 >> 6) - 2; if (kt_lo < 0) kt_lo = 0; }
    const bf16_t* dsrc[3]; unsigned dstr[3];
#pragma unroll
    for (int j = 0; j < 3; ++j) {
        const int c = (wid + 8 * j) * 64 + lane;
        const bf16_t* ptr; long strd;
        if (c < 832) {
            const int row = c / 13, col = c - row * 13;
            if (MODE == 0 && col >= 8 && col < 12) { ptr = KRp + ((long)tok0 + row) * 32 + (col - 8) * 8; strd = (long)64 * 32; }
            else { const int cc = (col < 8) ? col : 0; ptr = Kp + ((long)tok0 + (long)row * dil) * ldk + cc * 8; strd = (long)64 * dil * ldk; }
        } else if (c < 1408) {
            const int c2 = c - 832, row = c2 / 9, col = c2 - row * 9, cc = (col < 8) ? col : 0;
            ptr = Vp + ((long)tok0 + (long)row * dil) * ldv + cc * 8; strd = (long)64 * dil * ldv;
        } else { ptr = Vp + ((long)tok0) * ldv; strd = (long)64 * dil * ldv; }
        dsrc[j] = ptr + (long)kt_lo * strd; dstr[j] = (unsigned)(strd * 2);
    }
    LAS float* tab = (LAS float*)(lds + A_TAB);
    if constexpr (MODE == 1) tab[tid] = bias_g[tid];
#define ATT_DMA(ti_, stg_) do { if ((ti_) <= nt_m1) { \
        _Pragma("unroll") for (int j_ = 0; j_ < 3; ++j_) { const int slot_ = wid + 8 * j_; \
            if (slot_ < 22) { __builtin_amdgcn_global_load_lds((const unsigned*)dsrc[j_], (LAS unsigned*)(lds + (stg_) * A_STAGE + slot_ * 1024), 16, 0, 0); \
                              dsrc[j_] = (const bf16_t*)((const char*)dsrc[j_] + dstr[j_]); } } } } while (0)
    const int nt_m1 = kt_hi - kt_lo;
    ATT_DMA(0, 0); ATT_DMA(1, 1);
    asm volatile("s_waitcnt vmcnt(0)" ::: "memory");
    __syncthreads();
    f32x16 o0, o1;
#pragma unroll
    for (int i = 0; i < 16; ++i) { o0[i] = 0.f; o1[i] = 0.f; }
    float mrun = -1e29f, lrun = 0.f;
    if (has_sink) { mrun = sink2; lrun = (h == 0) ? 1.f : 0.f; }
    const float sc = (MODE == 0) ? cscale : 1.0f;
    const unsigned kfo = ql * AK_STRIDE + h * 16;
    const unsigned vfo = AV_OFF + (4 * h + ((lane & 15) >> 2)) * AV_STRIDE + (16 * ((lane >> 4) & 1) + 4 * (lane & 3)) * 2;

#define ATT_ACT(kt_) (((kt_) <= kt_hi) && ((kt_) * 64 <= qb) && (MODE == 0 || ((kt_) * 64 + 63 >= qa - W)))
    f32x16 s0, s1;
#pragma unroll 1
    for (int kt = kt_lo; kt <= kt_hi; ++kt) {
        const int ti = kt - kt_lo, stg = ti & 3;
        const bool act_t = ATT_ACT(kt);
        if (!act_t && (ti & 1) == 0) { ATT_DMA(ti + 2, (ti + 2) & 3); ATT_DMA(ti + 3, (ti + 3) & 3); }
        if (act_t) {
            LAS const unsigned char* sb = lds + stg * A_STAGE;
            bf16x8 kf[2 * NKS];
#pragma unroll
            for (int s = 0; s < NKS; ++s) { kf[2 * s] = *(LAS const bf16x8*)(sb + kfo + s * 32); kf[2 * s + 1] = *(LAS const bf16x8*)(sb + kfo + 32 * AK_STRIDE + s * 32); }
            s16x4 vf[16];
#pragma unroll
            for (int n = 0; n < 2; ++n)
#pragma unroll
                for (int s2 = 0; s2 < 2; ++s2) {
                    LAS const unsigned char* vp = sb + vfo + (32 * n + 16 * s2) * AV_STRIDE;
                    vf[(n * 2 + s2) * 4 + 0] = vtr(vp); vf[(n * 2 + s2) * 4 + 1] = vtr(vp + 8 * AV_STRIDE); vf[(n * 2 + s2) * 4 + 2] = vtr(vp + 64); vf[(n * 2 + s2) * 4 + 3] = vtr(vp + 8 * AV_STRIDE + 64);
                }
            __builtin_amdgcn_sched_barrier(0);
#pragma unroll
            for (int i = 0; i < 16; ++i) { s0[i] = 0.f; s1[i] = 0.f; }
#pragma unroll
            for (int s = 0; s < NKS; ++s) { s0 = MFMA32(kf[2 * s], qf[s], s0); s1 = MFMA32(kf[2 * s + 1], qf[s], s1); }
            __builtin_amdgcn_sched_barrier(0);
            if ((ti & 1) == 0) { ATT_DMA(ti + 2, (ti + 2) & 3); ATT_DMA(ti + 3, (ti + 3) & 3); }
            __builtin_amdgcn_sched_barrier(0);
            const int kbase = kt * 64;
            if constexpr (MODE == 0) {
                if (kbase + 63 > qa) {
                    const int dlt = qsub - kbase - 4 * h;
#pragma unroll
                    for (int i = 0; i < 16; ++i) { const int ci = (i & 3) + 8 * (i >> 2); if (ci > dlt) s0[i] = -1e30f; if (ci + 32 > dlt) s1[i] = -1e30f; }
                }
            } else {
                LAS const float* tb = tab + (qsub - kbase + 128 - 4 * h - 59);
#pragma unroll
                for (int i = 0; i < 16; ++i) { const int ci = (i & 3) + 8 * (i >> 2);
                    s0[i] = __builtin_fmaf(s0[i], cscale, tb[59 - ci]); s1[i] = __builtin_fmaf(s1[i], cscale, tb[27 - ci]); }
            }
            float mxa, mxb;
            if constexpr (MODE == 0) asm volatile("s_nop 15\n\ts_nop 3" : "+v"(s0), "+v"(s1));
            asm("v_max3_f32 %0, %1, %2, %3\n\tv_max3_f32 %0, %0, %4, %5\n\tv_max3_f32 %0, %0, %6, %7\n\tv_max3_f32 %0, %0, %8, %9\n\tv_max3_f32 %0, %0, %10, %11\n\tv_max3_f32 %0, %0, %12, %13\n\tv_max3_f32 %0, %0, %14, %15\n\tv_max3_f32 %0, %0, %16, %16"
                : "=&v"(mxa) : "v"(s0[0]), "v"(s0[1]), "v"(s0[2]), "v"(s0[3]), "v"(s0[4]), "v"(s0[5]), "v"(s0[6]), "v"(s0[7]), "v"(s0[8]), "v"(s0[9]), "v"(s0[10]), "v"(s0[11]), "v"(s0[12]), "v"(s0[13]), "v"(s0[14]), "v"(s0[15]));
            asm("v_max3_f32 %0, %1, %2, %3\n\tv_max3_f32 %0, %0, %4, %5\n\tv_max3_f32 %0, %0, %6, %7\n\tv_max3_f32 %0, %0, %8, %9\n\tv_max3_f32 %0, %0, %10, %11\n\tv_max3_f32 %0, %0, %12, %13\n\tv_max3_f32 %0, %0, %14, %15\n\tv_max3_f32 %0, %0, %16, %16"
                : "=&v"(mxb) : "v"(s1[0]), "v"(s1[1]), "v"(s1[2]), "v"(s1[3]), "v"(s1[4]), "v"(s1[5]), "v"(s1[6]), "v"(s1[7]), "v"(s1[8]), "v"(s1[9]), "v"(s1[10]), "v"(s1[11]), "v"(s1[12]), "v"(s1[13]), "v"(s1[14]), "v"(s1[15]));
            const float mxl = fmaxf(mxa, mxb);
            if (__builtin_amdgcn_ballot_w64((mxl - mrun) * sc > 8.0f) != 0ull) {
                const float mx = fmaxf(mxl, __shfl_xor(mxl, 32));
                const float mn = fmaxf(mrun, mx), alpha = __builtin_amdgcn_exp2f((mrun - mn) * sc); mrun = mn; lrun *= alpha;
#pragma unroll
                for (int i = 0; i < 16; ++i) { o0[i] *= alpha; o1[i] *= alpha; }
            }
            const float nm = -mrun * sc; float ps = 0.f;
#pragma unroll
            for (int i = 0; i < 16; ++i) {
                if constexpr (MODE == 0) { s0[i] = __builtin_amdgcn_exp2f(__builtin_fmaf(s0[i], sc, nm)); s1[i] = __builtin_amdgcn_exp2f(__builtin_fmaf(s1[i], sc, nm)); }
                else { s0[i] = __builtin_amdgcn_exp2f(s0[i] + nm); s1[i] = __builtin_amdgcn_exp2f(s1[i] + nm); }
                ps += s0[i] + s1[i];
            }
            lrun += ps;
            bf16x8 pk[2][2];
            pk[0][0] = __builtin_bit_cast(bf16x8, __builtin_convertvector(__builtin_shufflevector(s0, s0, 0, 1, 2, 3, 4, 5, 6, 7), bf16x8_t));
            pk[0][1] = __builtin_bit_cast(bf16x8, __builtin_convertvector(__builtin_shufflevector(s0, s0, 8, 9, 10, 11, 12, 13, 14, 15), bf16x8_t));
            pk[1][0] = __builtin_bit_cast(bf16x8, __builtin_convertvector(__builtin_shufflevector(s1, s1, 0, 1, 2, 3, 4, 5, 6, 7), bf16x8_t));
            pk[1][1] = __builtin_bit_cast(bf16x8, __builtin_convertvector(__builtin_shufflevector(s1, s1, 8, 9, 10, 11, 12, 13, 14, 15), bf16x8_t));
#pragma unroll
            for (int n = 0; n < 2; ++n)
#pragma unroll
                for (int s2 = 0; s2 < 2; ++s2) {
                    const int b4 = (n * 2 + s2) * 4;
                    const bf16x8 v0 = __builtin_shufflevector(vf[b4], vf[b4 + 1], 0, 1, 2, 3, 4, 5, 6, 7), v1 = __builtin_shufflevector(vf[b4 + 2], vf[b4 + 3], 0, 1, 2, 3, 4, 5, 6, 7);
                    o0 = MFMA32(v0, pk[n][s2], o0); o1 = MFMA32(v1, pk[n][s2], o1);
                }
        }
        if (ti & 1) { asm volatile("s_waitcnt vmcnt(0) lgkmcnt(0)" ::: "memory"); __builtin_amdgcn_s_barrier(); asm volatile("" ::: "memory"); }
    }
#undef ATT_DMA
#undef ATT_ACT
#undef ATT_QK
#undef ATT_SM1
#undef ATT_SM2
    const float ltot = lrun + __shfl_xor(lrun, 32), inv = 1.0f / ltot;
    bf16_t* op = Op + qtok * ldo;
#pragma unroll
    for (int g4 = 0; g4 < 4; ++g4) {
        u32x2 w0, w1;
        w0.x = cvt_pk_bf16(o0[4 * g4] * inv, o0[4 * g4 + 1] * inv); w0.y = cvt_pk_bf16(o0[4 * g4 + 2] * inv, o0[4 * g4 + 3] * inv);
        w1.x = cvt_pk_bf16(o1[4 * g4] * inv, o1[4 * g4 + 1] * inv); w1.y = cvt_pk_bf16(o1[4 * g4 + 2] * inv, o1[4 * g4 + 3] * inv);
        *(u32x2*)(op + 8 * g4 + 4 * h) = w0; *(u32x2*)(op + 32 + 8 * g4 + 4 * h) = w1;
    }
    if (MODE == 1 && lse_out != nullptr && h == 0) lse_out[qtok * ld_lse] = (mrun + __builtin_amdgcn_logf(ltot)) * LN2;
}

__constant__ float c_rope_inv[16] = {1.0f, 0.5623413324356079f, 0.3162277638912201f, 0.17782793939113617f, 0.10000000149011612f, 0.05623413249850273f, 0.03162277489900589f,
    0.017782794311642647f, 0.009999999776482582f, 0.005623413249850273f, 0.003162277629598975f, 0.0017782794311642647f, 0.0010000000474974513f, 0.000562341301701963f,
    0.0003162277571391314f, 0.00017782794020604342f};

struct Job { const float* src; bf16_t* dst; const float* gain; int K, N, Npad; };
DI Job get_job(const Params& p, int j) {
    bf16_t* wb = (bf16_t*)(p.ws + WS_W); Job J;
    if (j < 2)       { const int e = j;      J = Job{p.in[5] + (size_t)e * 1024 * 3072, wb + W_IN + (size_t)e * 3145728, p.in[2] + (size_t)(2 * e) * 1024, 1024, 3072, 3072}; }
    else if (j < 4)  { const int e = j - 2;  J = Job{p.in[7] + (size_t)e * 768 * 1024, wb + W_OUT + (size_t)e * 786432, nullptr, 768, 1024, 1024}; }
    else if (j < 6)  { const int o = j - 4;  J = Job{p.in[8] + (size_t)o * 1024 * 672, wb + W_DC + (size_t)o * 786432, p.in[2] + (size_t)(2 * o + 1) * 1024, 1024, 672, 768}; }
    else if (j < 8)  { const int o = j - 6;  J = Job{p.in[10] + (size_t)o * 384 * 768, wb + W_UQ + (size_t)o * 294912, p.in[9] + (size_t)o * 384, 384, 768, 768}; }
    else if (j < 10) { const int o = j - 8;  J = Job{p.in[12] + (size_t)o * 256 * 1024, wb + W_UKV + (size_t)o * 262144, p.in[11] + (size_t)o * 256, 256, 1024, 1024}; }
    else if (j < 12) { const int o = j - 10; J = Job{p.in[13] + (size_t)o * 512 * 1024, wb + W_O + (size_t)o * 524288, nullptr, 512, 1024, 1024}; }
    else if (j < 16) { const int l = j - 12; J = Job{p.in[14] + (size_t)l * 1024 * 4096, wb + W_UP + (size_t)l * 4194304, p.in[3] + (size_t)l * 1024, 1024, 4096, 4096}; }
    else             { const int l = j - 16; J = Job{p.in[15] + (size_t)l * 4096 * 1024, wb + W_DN + (size_t)l * 4194304, nullptr, 4096, 1024, 1024}; }
    return J;
}

DI int t5_bucket(int n) {
    if (n < 16) return n;
    const float nf = (float)n;
    int large = 16 + (int)(__logf(nf / 16.0f) / 4.852030263919617f * 16.0f);
    return large < 31 ? large : 31;
}

DI void prologue(const Params& p, LAS unsigned char* lds) {
    const int tid = opaque_tid(), G = gridDim.x, bid = blockIdx.x;
    {
        const int gw = bid * 8 + (tid >> 6), GW = G * 8, lane = tid & 63;
        int base = 0;
#pragma unroll 1
        for (int j = 0; j < 20; ++j) {
            const Job J = get_job(p, j);
            const int nnb = J.Npad / 256, items = (J.K / 8) * nnb;
#pragma unroll 1
            for (int it = (gw - (base % GW) + GW) % GW; it < items; it += GW) {
                const int kc = it / nnb, nb = it - kc * nnb, n = nb * 256 + lane * 4, k0 = kc * 8;
                f32x4 v[8];
                if (n < J.N) {
#pragma unroll
                    for (int q = 0; q < 8; ++q) v[q] = *(const f32x4*)(J.src + (size_t)(k0 + q) * J.N + n);
                    if (J.gain) {
                        const f32x4 g0 = *(const f32x4*)(J.gain + k0), g1 = *(const f32x4*)(J.gain + k0 + 4);
                        v[0] *= g0[0]; v[1] *= g0[1]; v[2] *= g0[2]; v[3] *= g0[3]; v[4] *= g1[0]; v[5] *= g1[1]; v[6] *= g1[2]; v[7] *= g1[3];
                    }
                } else {
#pragma unroll
                    for (int q = 0; q < 8; ++q) v[q] = (f32x4){0.f, 0.f, 0.f, 0.f};
                }
#pragma unroll
                for (int e = 0; e < 4; ++e) {
                    u32x4 w; w.x = cvt_pk_bf16(v[0][e], v[1][e]); w.y = cvt_pk_bf16(v[2][e], v[3][e]); w.z = cvt_pk_bf16(v[4][e], v[5][e]); w.w = cvt_pk_bf16(v[6][e], v[7][e]);
                    *(u32x4*)(J.dst + (size_t)(n + e) * J.K + k0) = w;
                }
            }
            base += items;
        }
    }
    {
        const float* x = p.in[0]; bf16_t* hb = (bf16_t*)(p.ws + WS_HB); float* partH = (float*)(p.ws + WS_PARTH);
        const int wid = tid >> 6, lane = tid & 63;
        for (int row0 = (bid * 8 + wid) * 2; row0 < T_TOK; row0 += G * 16) {
            f32x4 v[2][4];
#pragma unroll
            for (int r = 0; r < 2; ++r)
#pragma unroll
                for (int i = 0; i < 4; ++i) v[r][i] = *(const f32x4*)(x + (size_t)(row0 + r) * DM + i * 256 + lane * 4);
#pragma unroll
            for (int r = 0; r < 2; ++r) {
                float ss = 0.f;
#pragma unroll
                for (int i = 0; i < 4; ++i) {
                    const f32x4 t = v[r][i];
                    ss += (t[0] * t[0] + t[1] * t[1]) + (t[2] * t[2] + t[3] * t[3]);
                    u32x2 w; w.x = cvt_pk_bf16(t[0], t[1]); w.y = cvt_pk_bf16(t[2], t[3]);
                    *(u32x2*)(hb + (size_t)(row0 + r) * DM + i * 256 + lane * 4) = w;
                }
#pragma unroll
                for (int o = 32; o > 0; o >>= 1) ss += __shfl_xor(ss, o);
                if (lane < 4) partH[(size_t)(row0 + r) * 4 + lane] = (lane == 0) ? ss : 0.f;
            }
        }
    }
    {
        float* cs = (float*)(p.ws + WS_ROPE);
        for (int idx = bid * 512 + tid; idx < SEQ * 16; idx += G * 512) {
            const int pos = idx >> 4, i = idx & 15;
            const float ang = (float)pos * c_rope_inv[i];
            double rv = (double)ang * 0.15915494309189535; rv -= __builtin_rint(rv);
            const float r = (float)rv;
            cs[2 * idx] = __builtin_amdgcn_cosf(r); cs[2 * idx + 1] = __builtin_amdgcn_sinf(r);
        }
    }
    {
        float* bt = (float*)(p.ws + WS_BIAS); const float* rel = p.in[1];
        for (int idx = bid * 512 + tid; idx < 20 * 512; idx += G * 512) {
            const int hd = idx >> 9, dist = (idx & 511) - 128;
            int dl = 1, W = 127;
            if (hd >= 8) { const int g = (hd - 8) >> 2; dl = (g == 0) ? 1 : (g == 1 ? 4 : 16); W = 128; }
            float v = -1e30f;
            if (dist >= 0 && dist <= W) v = rel[t5_bucket(dist * dl) * 20 + hd] * LOG2E;
            bt[idx] = v;
        }
    }
}

extern __shared__ __attribute__((aligned(16))) unsigned char smem_raw[];

struct GDesc { pg8::Gemm g; pg8::Epi E; };
DI GDesc get_gemm(const Params& p, int layer, int slot, int gi) {
    unsigned char* ws = p.ws;
    bf16_t* hb = (bf16_t*)(ws + WS_HB); bf16_t* wb = (bf16_t*)(ws + WS_W);
    float* partH = (float*)(ws + WS_PARTH); float* partO = (float*)(ws + WS_PARTO);
    bf16_t* att = (bf16_t*)(ws + WS_R + R_ATT);
    const int even = (layer & 1) == 0, li = layer >> 1;
    GDesc d;
    const float* rstd = (const float*)(ws + WS_RSTD);
    d.E.mode = 0; d.E.rstd = partH; d.E.rs4 = 1; d.E.relu2 = 0; d.E.part_out = nullptr; d.E.O = hb; d.E.ldo = DM;
    d.g.M = T_TOK;
    if (slot == 0) {
        if (even) { d.g.A = hb; d.g.lda = DM; d.g.Bt = wb + W_IN + (size_t)li * 3145728; d.g.N = 3072; d.g.K = 1024; d.E.O = (bf16_t*)(ws + WS_R + R_PROJ); d.E.ldo = 3072; }
        else      { d.g.A = hb; d.g.lda = DM; d.g.Bt = wb + W_DC + (size_t)li * 786432; d.g.N = 768; d.g.K = 1024; d.E.O = (bf16_t*)(ws + WS_R + R_DOWN); d.E.ldo = 768; d.E.part_out = partO; }
    } else if (slot == 1) {
        bf16_t* down = (bf16_t*)(ws + WS_R + R_DOWN);
        if (gi == 0) { d.g.A = down; d.g.lda = 768; d.g.Bt = wb + W_UQ + (size_t)li * 294912; d.g.N = 768; d.g.K = 384; d.E.O = (bf16_t*)(ws + WS_R + R_Q); d.E.ldo = 768; d.E.rstd = rstd + T_TOK; d.E.rs4 = 0; }
        else         { d.g.A = down + 384; d.g.lda = 768; d.g.Bt = wb + W_UKV + (size_t)li * 262144; d.g.N = 1024; d.g.K = 256; d.E.O = (bf16_t*)(ws + WS_R + R_KV); d.E.ldo = 1024; d.E.rstd = rstd + 2 * T_TOK; d.E.rs4 = 0; }
    } else if (slot == 3) {
        d.E.mode = 1; d.E.part_out = partH;
        if (even) { d.g.A = att; d.g.lda = 768; d.g.Bt = wb + W_OUT + (size_t)li * 786432; d.g.N = 1024; d.g.K = 768; }
        else      { d.g.A = att; d.g.lda = 512; d.g.Bt = wb + W_O + (size_t)li * 524288; d.g.N = 1024; d.g.K = 512; }
    } else if (slot == 4) {
        d.g.A = hb; d.g.lda = DM; d.g.Bt = wb + W_UP + (size_t)layer * 4194304; d.g.N = DFF; d.g.K = 1024; d.E.O = (bf16_t*)(ws + WS_R + R_HID); d.E.ldo = DFF; d.E.relu2 = 1;
    } else {
        d.E.mode = 1; d.E.part_out = partH;
        d.g.A = (bf16_t*)(ws + WS_R + R_HID); d.g.lda = DFF; d.g.Bt = wb + W_DN + (size_t)layer * 4194304; d.g.N = 1024; d.g.K = DFF;
    }
    return d;
}

__global__ void __launch_bounds__(512) trunk_fwd(Params p) {
    cg::grid_group grid = cg::this_grid();
    LAS unsigned char* lds = (LAS unsigned char*)smem_raw;
    const int G = gridDim.x, bid = blockIdx.x;

    volatile LAS unsigned* xst = (volatile LAS unsigned*)(lds + LDS_MAIN);
    if (threadIdx.x < 2) xst[threadIdx.x] = 0u;
    __syncthreads();
    const XcdBarrier xb = xcd_barrier_post((unsigned*)(p.ws + WS_BAR), xst);
#pragma unroll 1
    for (int rep = 0; rep < REP_P0; ++rep) prologue(p, lds);
    grid.sync();

#pragma unroll 1
    for (int layer = 0; layer < 4; ++layer) {
        const int even = (layer & 1) == 0, li = layer >> 1;
#pragma unroll 1
        for (int slot = 0; slot < 6; ++slot) {
            const int ng = (slot == 0 || slot >= 3) ? 1 : ((slot == 1 && !even) ? 2 : 0);
            if (slot == 1 && !even) {
                const int tid = opaque_tid(), j = tid & 7;
                const float* partO = (const float*)(p.ws + WS_PARTO); float* rstd = (float*)(p.ws + WS_RSTD);
                for (int row = bid * 64 + (tid >> 3); row < T_TOK; row += G * 64) {
                    const f32x4 v = *(const f32x4*)(partO + (size_t)row * 32 + j * 4);
                    const float s = (v[0] + v[1]) + (v[2] + v[3]);
                    float sq = (j < 3) ? s : 0.f, sk = (j >= 3 && j < 5) ? s : 0.f;
                    sq += __shfl_xor(sq, 1); sq += __shfl_xor(sq, 2); sq += __shfl_xor(sq, 4);
                    sk += __shfl_xor(sk, 1); sk += __shfl_xor(sk, 2); sk += __shfl_xor(sk, 4);
                    if (j == 0) { rstd[T_TOK + row] = __builtin_amdgcn_rsqf(sq * (1.0f / 384.0f) + EPSN); rstd[2 * T_TOK + row] = __builtin_amdgcn_rsqf(sk * (1.0f / 256.0f) + EPSN); }
                }
                xcd_barrier(xb);
            }
#pragma unroll 1
            for (int gi0 = 0; gi0 < ng * ((slot == 4) ? REP_M1 : 1); ++gi0) {
                const int gi = (slot == 4) ? 0 : gi0;
                const GDesc d = get_gemm(p, layer, slot, gi);
                pg8::StaticOrder S; S.init(d.g.M, d.g.N, G, bid);
                pg8::gemm_phase(lds, d.g, S, d.E);
            }
            unsigned char* ws = p.ws;
            const int tid = opaque_tid();
            if (slot == 1 && even) {
                const bf16_t* proj = (const bf16_t*)(ws + WS_R + R_PROJ);
                bf16_t* att = (bf16_t*)(ws + WS_R + R_ATT);
                bf16_t* obuf = (bf16_t*)(ws + WS_OBUF);
                float* lseb = (float*)(ws + WS_LSE);
                const float* biasT = (const float*)(ws + WS_BIAS);
#pragma unroll 1
                for (int u0 = bid; u0 < 2560 * REP_E2; u0 += G) {
                    const int u = u0 % 2560;
                    int qc, kc, vc, ldo, ld_lse, W, tok0, dl, q0, has_sink, bh; bf16_t* op; float* lp; float sink2 = 0.f;
                    if (u < 1024) {
                        const int b = u >> 9, hq = (u >> 6) & 7, qblk = u & 63, kvh = hq >> 2;
                        qc = hq * 64; kc = 512 + kvh * 64; vc = 640 + kvh * 64; op = att + hq * 64; ldo = 768; lp = nullptr; ld_lse = 0; bh = hq;
                        sink2 = p.in[6][li * 8 + hq] * LOG2E; has_sink = 1; W = 127; tok0 = b * SEQ; dl = 1; q0 = qblk * 256;
                    } else {
                        const int v = u - 1024, g = v >> 9, w = v & 511, b = w >> 8, hbh = (w >> 6) & 3, j = w & 63;
                        dl = (g == 0) ? 1 : (g == 1 ? 4 : 16); const int nqb = 64 / dl, r = j / nqb, qblk = j % nqb;
                        qc = 768 + ((g * 3 + 0) * 4 + hbh) * 64; kc = 768 + ((g * 3 + 1) * 4 + hbh) * 64; vc = 768 + ((g * 3 + 2) * 4 + hbh) * 64;
                        op = obuf + (size_t)g * T_TOK * 256 + hbh * 64; ldo = 256; lp = lseb + (size_t)g * T_TOK * 4 + hbh; ld_lse = 4; bh = 8 + g * 4 + hbh;
                        has_sink = 0; W = 128; tok0 = b * SEQ + r; q0 = qblk * 256;
                    }
                    attn_unit<1>(lds, proj + qc, 3072, proj + kc, 3072, nullptr, proj + vc, 3072, op, ldo, lp, ld_lse,
                                 nullptr, biasT + bh * 512, sink2, has_sink, W, tok0, dl, q0, 0.18033688011112042f);
                }
            } else if (slot == 2 && even) {
                bf16_t* att = (bf16_t*)(ws + WS_R + R_ATT);
                const bf16_t* obuf = (const bf16_t*)(ws + WS_OBUF);
                const float* lseb = (const float*)(ws + WS_LSE);
                for (int idx = bid * 512 + tid; idx < T_TOK * 32; idx += G * 512) {
                    const int tok = idx >> 5, hbh = (idx >> 3) & 3, c = idx & 7;
                    const float l0 = lseb[(size_t)tok * 4 + hbh], l1 = lseb[(size_t)(T_TOK + tok) * 4 + hbh], l2 = lseb[(size_t)(2 * T_TOK + tok) * 4 + hbh];
                    const float mx = fmaxf(l0, fmaxf(l1, l2));
                    float w0 = __expf(l0 - mx), w1 = __expf(l1 - mx), w2 = __expf(l2 - mx);
                    const float inv = 1.0f / (w0 + w1 + w2); w0 *= inv; w1 *= inv; w2 *= inv;
                    const size_t oo = (size_t)tok * 256 + hbh * 64 + c * 8;
                    const u32x4 a = *(const u32x4*)(obuf + oo), b = *(const u32x4*)(obuf + (size_t)T_TOK * 256 + oo), d = *(const u32x4*)(obuf + (size_t)2 * T_TOK * 256 + oo);
                    u32x4 r;
#pragma unroll
                    for (int k = 0; k < 4; ++k)
                        r[k] = cvt_pk_bf16(w0 * bflo(a[k]) + w1 * bflo(b[k]) + w2 * bflo(d[k]), w0 * bfhi(a[k]) + w1 * bfhi(b[k]) + w2 * bfhi(d[k]));
                    *(u32x4*)(att + (size_t)tok * 768 + 512 + hbh * 64 + c * 8) = r;
                }
            } else if (slot == 1 && !even) {
                const bf16_t* down = (const bf16_t*)(ws + WS_R + R_DOWN);
                bf16_t* krope = (bf16_t*)(ws + WS_R + R_KROPE);
                const float* rope_cs = (const float*)(ws + WS_ROPE);
                for (int idx = bid * 512 + tid; idx < T_TOK * 16; idx += G * 512) {
                    const int tok = idx >> 4, i = idx & 15, pos = tok & (SEQ - 1);
                    const float t1 = bf2f(down[(size_t)tok * 768 + 640 + i]), t2 = bf2f(down[(size_t)tok * 768 + 656 + i]);
                    const f32x2 cs = *(const f32x2*)(rope_cs + ((size_t)pos * 16 + i) * 2);
                    krope[(size_t)tok * 32 + i] = (bf16_t)(cvt_pk_bf16(t1 * cs[0] - t2 * cs[1], 0.f) & 0xffffu);
                    krope[(size_t)tok * 32 + 16 + i] = (bf16_t)(cvt_pk_bf16(t1 * cs[1] + t2 * cs[0], 0.f) & 0xffffu);
                }
            } else if (slot == 2 && !even) {
                const bf16_t* qbuf = (const bf16_t*)(ws + WS_R + R_Q);
                const bf16_t* kvb = (const bf16_t*)(ws + WS_R + R_KV);
                const bf16_t* krope = (const bf16_t*)(ws + WS_R + R_KROPE);
                bf16_t* att = (bf16_t*)(ws + WS_R + R_ATT);
                const float* rope_cs = (const float*)(ws + WS_ROPE);
                const int vbid = (G == 256) ? ((bid & 7) * 32 + (bid >> 3)) : bid;
#pragma unroll 1
                for (int it0 = vbid; it0 < 1024 * REP_O3; it0 += G) {
                    const int it = it0 % 1024;
                    const int half = it / 512, pr = it % 512;
                    const int bh = pr >> 5, x = pr & 31, b = bh >> 3, hh = bh & 7;
                    const int qblk = half == 0 ? 63 - x : x;
                    attn_unit<0>(lds, qbuf + hh * 96, 768, kvb + hh * 128, 1024, krope, kvb + hh * 128 + 64, 1024, att + hh * 64, 512, nullptr, 0,
                                 rope_cs, nullptr, 0.f, 0, 0, b * SEQ, 1, qblk * 256, 0.14724444602590306f);
                }
            }
            for (int rs_ = 0; rs_ < REP_SYNC; ++rs_) xcd_barrier(xb);
        }
    }
    {
        const float* fn = p.in[4]; float* outp = p.out; const float* partH = (const float*)(p.ws + WS_PARTH); const bf16_t* hb = (const bf16_t*)(p.ws + WS_HB);
        const int tid = opaque_tid(), wid = tid >> 6, lane = tid & 63;
        for (int row = bid * 8 + wid; row < T_TOK; row += G * 8) {
            const f32x4 pa = *(const f32x4*)(partH + (size_t)row * 4);
            const float ss = (pa[0] + pa[1]) + (pa[2] + pa[3]);
            const float rs = __builtin_amdgcn_rsqf(ss * (1.0f / 1024.0f) + EPSN);
#pragma unroll
            for (int i = 0; i < 2; ++i) {
                const size_t o = (size_t)row * DM + i * 512 + lane * 8;
                const u32x4 r = *(const u32x4*)(hb + o);
                const f32x4 g0 = *(const f32x4*)(fn + i * 512 + lane * 8), g1 = *(const f32x4*)(fn + i * 512 + lane * 8 + 4);
                f32x4 v0, v1;
                v0[0] = bflo(r.x) * rs * g0[0]; v0[1] = bfhi(r.x) * rs * g0[1]; v0[2] = bflo(r.y) * rs * g0[2]; v0[3] = bfhi(r.y) * rs * g0[3];
                v1[0] = bflo(r.z) * rs * g1[0]; v1[1] = bfhi(r.z) * rs * g1[1]; v1[2] = bflo(r.w) * rs * g1[2]; v1[3] = bfhi(r.w) * rs * g1[3];
                *(f32x4*)(outp + o) = v0; *(f32x4*)(outp + o + 4) = v1;
            }
        }
    }
}

extern "C" void kernel_launch(void* const* d_in, const int* in_sizes, int n_in, void* d_out, int out_size, void* d_ws, size_t ws_size, hipStream_t stream) {
    static int grid_blocks = 0;
    if (grid_blocks == 0) {
        if (n_in != 16 || out_size != T_TOK * DM || ws_size < WS_END) { fprintf(stderr, "kernel_launch: unexpected shapes (n_in %d out %d ws %zu)\n", n_in, out_size, ws_size); grid_blocks = -1; return; }
        int dev = 0, cus = 0, per_cu = 0;
        hipGetDevice(&dev);
        hipDeviceGetAttribute(&cus, hipDeviceAttributeMultiprocessorCount, dev);
        if (hipFuncSetAttribute((const void*)trunk_fwd, hipFuncAttributeMaxDynamicSharedMemorySize, LDS_BYTES) != hipSuccess) { fprintf(stderr, "kernel_launch: hipFuncSetAttribute failed\n"); grid_blocks = -1; return; }
        if (hipOccupancyMaxActiveBlocksPerMultiprocessor(&per_cu, (const void*)trunk_fwd, 512, LDS_BYTES) != hipSuccess || per_cu < 1) { fprintf(stderr, "kernel_launch: occupancy query gave %d\n", per_cu); per_cu = 1; }
        (void)hipGetLastError();
        grid_blocks = cus * 1;
    }
    if (grid_blocks < 0) return;
    if (hipMemsetAsync((char*)d_ws + WS_BAR, 0, XCD_BAR_WORDS * sizeof(unsigned), stream) != hipSuccess) { fprintf(stderr, "kernel_launch: memset of barrier words failed\n"); return; }
    Params p{};
    for (int i = 0; i < 16; ++i) p.in[i] = (const float*)d_in[i];
    p.out = (float*)d_out; p.ws = (unsigned char*)d_ws;
    void* args[] = {&p};
    hipError_t e = hipLaunchCooperativeKernel((const void*)trunk_fwd, dim3(grid_blocks), dim3(512), args, LDS_BYTES, stream);
    if (e != hipSuccess) fprintf(stderr, "cooperative launch failed: %s (grid %d)\n", hipGetErrorString(e), grid_blocks);
}
```
